# Optimizing an MI355X kernel written in HIP

```python
import jax, jax.numpy as jnp
from jax import lax
import numpy as np

D_MODEL = 1024
BATCH = 2
SEQ = 8192
DEPTH = 2
DEC_BATCH = 128
DEC_SEQ = 4
PAST_LEN = 16384
PAGE_SIZE = 128

PLE_DIM = 256
POOL_WIDTH = D_MODEL
POOL_WINDOWS = (2, 4, 8, 16)
N_POOL_GROUPS = len(POOL_WINDOWS)
POOL_GROUP = POOL_WIDTH // N_POOL_GROUPS
POOL_STATE = max(POOL_WINDOWS) - 1
HEAD_DIM = 64
N_HEADS = D_MODEL // HEAD_DIM
N_KV_HEADS = 4
GQA_GROUP = N_HEADS // N_KV_HEADS
ATTN_WIDTH = N_HEADS * HEAD_DIM
KV_WIDTH = N_KV_HEADS * HEAD_DIM
WINDOW = 128
BLOCK = 128
ROPE_THETA = 500000.0
ROPE_DIM = HEAD_DIM // 4
EPS = 1e-6
IN_SPLIT_SIZES = (POOL_WIDTH, POOL_WIDTH, ATTN_WIDTH, KV_WIDTH, KV_WIDTH, ATTN_WIDTH, D_MODEL, D_MODEL)
IN_COLS = sum(IN_SPLIT_SIZES)
IN_SPLIT_POINTS = tuple(int(c) for c in np.cumsum(IN_SPLIT_SIZES)[:-1])

kernel_name = "hybrid_pool_swa_gated_decoder_step"


def rms_norm(x, g):
    xf = x.astype(jnp.float32)
    y = xf * lax.rsqrt(jnp.mean(xf * xf, axis=-1, keepdims=True) + EPS) * g.astype(jnp.float32)
    return y.astype(x.dtype)


def rope(x, pos):
    inv_freq = ROPE_THETA ** (-jnp.arange(0, ROPE_DIM, 2, dtype=jnp.float32) / ROPE_DIM)
    ang = pos.astype(jnp.float32)[:, None] * inv_freq[None, :]
    cos = jnp.cos(ang)[None, :, None, :]
    sin = jnp.sin(ang)[None, :, None, :]
    xr = x[..., :ROPE_DIM].astype(jnp.float32)
    x1, x2 = xr[..., :ROPE_DIM // 2], xr[..., ROPE_DIM // 2:]
    rot = jnp.concatenate([x1 * cos - x2 * sin, x2 * cos + x1 * sin], axis=-1).astype(x.dtype)
    return jnp.concatenate([rot, x[..., ROPE_DIM:]], axis=-1)


def multiscale_pool(u_pad, pos, pool_map, pool_scale):
    B, L, P = u_pad.shape
    T = L - POOL_STATE
    uf = u_pad.astype(jnp.float32)
    cs = jnp.concatenate([jnp.zeros_like(uf[:, :1]), jnp.cumsum(uf, axis=1)], axis=1)
    end = cs[:, POOL_STATE + 1:]
    u = uf[:, POOL_STATE:]
    outs = []
    for g, w in enumerate(POOL_WINDOWS):
        sl = slice(g * POOL_GROUP, (g + 1) * POOL_GROUP)
        start = cs[:, POOL_STATE + 1 - w: POOL_STATE + 1 - w + T, sl]
        cnt = jnp.minimum(pos + 1, w).astype(jnp.float32)[None, :, None]
        outs.append((end[..., sl] - start) / cnt - u[..., sl])
    r = jnp.stack(outs, axis=2)
    r = jnp.einsum('btgc,gcd->btgd', r, pool_map.astype(jnp.float32)).reshape(B, T, P)
    return (r * pool_scale.astype(jnp.float32)).astype(u_pad.dtype)


def sw_attention_core(q, k, v, qpos, kpos, sinks):
    s = jnp.einsum('bnqkgd,bnskd->bnkgqs', q.astype(jnp.float32), k.astype(jnp.float32)) * (HEAD_DIM ** -0.5)
    rel = qpos[:, :, None] - kpos[:, None, :]
    mask = (rel >= 0) & (rel <= WINDOW) & (kpos[:, None, :] >= 0)
    s = jnp.where(mask[None, :, None, None], s, -jnp.inf)
    sink = sinks.astype(jnp.float32).reshape(N_KV_HEADS, GQA_GROUP)[None, None, :, :, None, None]
    m = jnp.maximum(jnp.max(s, axis=-1, keepdims=True), sink)
    e = jnp.exp(s - m)
    pr = e / (jnp.sum(e, axis=-1, keepdims=True) + jnp.exp(sink - m))
    return jnp.einsum('bnkgqs,bnskd->bnqkgd', pr, v.astype(jnp.float32))


def layer(h, p_l, pos, pool_prev, k_prev, v_prev, norm_g, w_in, q_norm_g, k_norm_g, sinks,
          pool_map, pool_scale, w_proj_pool, w_proj_attn, w_out, w_ple, w_ple_gate):
    B, T, _ = h.shape
    xn = rms_norm(h, norm_g)
    z = xn @ w_in
    u, zp, q, k, v, za, ga, gb = jnp.split(z, IN_SPLIT_POINTS, axis=-1)
    if pool_prev is None:
        pool_prev = jnp.zeros((B, POOL_STATE, POOL_WIDTH), u.dtype)
    u_pad = jnp.concatenate([pool_prev, u], axis=1)
    ya = multiscale_pool(u_pad, pos, pool_map, pool_scale) * jax.nn.silu(zp)
    new_pool = u_pad[:, -POOL_STATE:]
    q = rope(rms_norm(q.reshape(B, T, N_HEADS, HEAD_DIM), q_norm_g), pos)
    k = rope(rms_norm(k.reshape(B, T, N_KV_HEADS, HEAD_DIM), k_norm_g), pos)
    v = v.reshape(B, T, N_KV_HEADS, HEAD_DIM)
    if k_prev is None:
        nb = T // BLOCK
        qb = q.reshape(B, nb, BLOCK, N_KV_HEADS, GQA_GROUP, HEAD_DIM)
        kb = k.reshape(B, nb, BLOCK, N_KV_HEADS, HEAD_DIM)
        vb = v.reshape(B, nb, BLOCK, N_KV_HEADS, HEAD_DIM)
        kcat = jnp.concatenate([jnp.concatenate([jnp.zeros_like(kb[:, :1]), kb[:, :-1]], axis=1), kb], axis=2)
        vcat = jnp.concatenate([jnp.concatenate([jnp.zeros_like(vb[:, :1]), vb[:, :-1]], axis=1), vb], axis=2)
        qpos = pos.reshape(nb, BLOCK)
        kpos = jnp.concatenate([qpos - BLOCK, qpos], axis=1)
        o = sw_attention_core(qb, kcat, vcat, qpos, kpos, sinks)
        new_k, new_v = k[:, -WINDOW:], v[:, -WINDOW:]
    else:
        kc = jnp.concatenate([k_prev, k], axis=1)
        vc = jnp.concatenate([v_prev, v], axis=1)
        kpos = jnp.concatenate([pos[0] - WINDOW + jnp.arange(WINDOW, dtype=jnp.int32), pos])[None]
        qb = q.reshape(B, 1, T, N_KV_HEADS, GQA_GROUP, HEAD_DIM)
        o = sw_attention_core(qb, kc[:, None], vc[:, None], pos[None], kpos, sinks)
        new_k, new_v = kc[:, -WINDOW:], vc[:, -WINDOW:]
    yb = o.reshape(B, T, ATTN_WIDTH).astype(h.dtype) * jax.nn.silu(za)
    m = jax.nn.sigmoid(ga) * (ya @ w_proj_pool) + jax.nn.sigmoid(gb) * (yb @ w_proj_attn)
    h = h + m @ w_out
    h = h + jax.nn.sigmoid(h @ w_ple_gate) * (p_l @ w_ple)
    return h, new_pool, new_k, new_v


def setup_inputs(seed: int = 0) -> dict:
    key = jax.random.key(seed)
    ks = jax.random.split(key, 20)
    f32 = jnp.float32
    nrm = lambda k, s, sc: jax.random.normal(k, s, f32) * sc
    return {
        "x_prompt": nrm(ks[0], (BATCH, SEQ, D_MODEL), 1.0),
        "x_sample": nrm(ks[1], (DEC_BATCH, DEC_SEQ, D_MODEL), 1.0),
        "cache_k": nrm(ks[2], (DEPTH, DEC_BATCH, WINDOW, N_KV_HEADS, HEAD_DIM), 1.0),
        "cache_v": nrm(ks[3], (DEPTH, DEC_BATCH, WINDOW, N_KV_HEADS, HEAD_DIM), 1.0),
        "state_pool": nrm(ks[4], (DEPTH, DEC_BATCH, POOL_STATE, POOL_WIDTH), 1.0),
        "p_prompt": nrm(ks[5], (DEPTH, BATCH, SEQ, PLE_DIM), 1.0),
        "p_sample": nrm(ks[6], (DEPTH, DEC_BATCH, DEC_SEQ, PLE_DIM), 1.0),
        "norm_g": 1.0 + nrm(ks[7], (DEPTH, D_MODEL), 0.05),
        "w_in": nrm(ks[8], (DEPTH, D_MODEL, IN_COLS), D_MODEL ** -0.5),
        "q_norm_g": 1.0 + nrm(ks[9], (DEPTH, HEAD_DIM), 0.05),
        "k_norm_g": 1.0 + nrm(ks[10], (DEPTH, HEAD_DIM), 0.05),
        "sinks": nrm(ks[11], (DEPTH, N_HEADS), 0.5),
        "pool_map": nrm(ks[12], (DEPTH, N_POOL_GROUPS, POOL_GROUP, POOL_GROUP), POOL_GROUP ** -0.5),
        "pool_scale": 1.0 + nrm(ks[13], (DEPTH, POOL_WIDTH), 0.1),
        "w_proj_pool": nrm(ks[14], (DEPTH, POOL_WIDTH, D_MODEL), POOL_WIDTH ** -0.5),
        "w_proj_attn": nrm(ks[15], (DEPTH, ATTN_WIDTH, D_MODEL), ATTN_WIDTH ** -0.5),
        "w_out": nrm(ks[16], (DEPTH, D_MODEL, D_MODEL), D_MODEL ** -0.5),
        "w_ple": nrm(ks[17], (DEPTH, PLE_DIM, D_MODEL), PLE_DIM ** -0.5),
        "w_ple_gate": nrm(ks[18], (DEPTH, D_MODEL, D_MODEL), D_MODEL ** -0.5),
    }


def reference(x_prompt, x_sample, cache_k, cache_v, state_pool, p_prompt, p_sample,
              norm_g, w_in, q_norm_g, k_norm_g, sinks, pool_map, pool_scale,
              w_proj_pool, w_proj_attn, w_out, w_ple, w_ple_gate):
    pos_prompt = jnp.arange(SEQ, dtype=jnp.int32)
    pos_sample = PAST_LEN + jnp.arange(DEC_SEQ, dtype=jnp.int32)
    hp, hs = x_prompt, x_sample
    kp_l, vp_l, pp_l, ks_l, vs_l, ps_l = [], [], [], [], [], []
    for i in range(DEPTH):
        w = (norm_g[i], w_in[i], q_norm_g[i], k_norm_g[i], sinks[i], pool_map[i], pool_scale[i],
             w_proj_pool[i], w_proj_attn[i], w_out[i], w_ple[i], w_ple_gate[i])
        hp, npool, nk, nv = layer(hp, p_prompt[i], pos_prompt, None, None, None, *w)
        pp_l.append(npool); kp_l.append(nk); vp_l.append(nv)
        hs, npool, nk, nv = layer(hs, p_sample[i], pos_sample, state_pool[i], cache_k[i], cache_v[i], *w)
        ps_l.append(npool); ks_l.append(nk); vs_l.append(nv)
    new_k_prompt = jnp.stack(kp_l, axis=0)
    new_v_prompt = jnp.stack(vp_l, axis=0)
    new_pool_prompt = jnp.stack(pp_l, axis=0)
    new_k_sample = jnp.stack(ks_l, axis=0)
    new_v_sample = jnp.stack(vs_l, axis=0)
    new_pool_sample = jnp.stack(ps_l, axis=0)
    return (hp, hs, new_k_prompt, new_v_prompt, new_pool_prompt, new_k_sample, new_v_sample, new_pool_sample)
```

```cpp
#include <hip/hip_runtime.h>
#include <hip/hip_cooperative_groups.h>
#include <cstdio>
#include <cmath>
namespace cg = cooperative_groups;

#ifndef COOP
#define COOP 1
#endif
#ifndef ONLY
#define ONLY -1
#endif

#define LAS __attribute__((address_space(3)))
#define DI __device__ __forceinline__
typedef unsigned short bf16_t;
typedef short bf16x8 __attribute__((ext_vector_type(8)));
typedef short s16x4 __attribute__((ext_vector_type(4)));
typedef float f32x2 __attribute__((ext_vector_type(2)));
typedef float f32x4 __attribute__((ext_vector_type(4)));
typedef float f32x16 __attribute__((ext_vector_type(16)));
typedef unsigned u32x2 __attribute__((ext_vector_type(2)));
typedef unsigned u32x4 __attribute__((ext_vector_type(4)));
typedef __bf16 bf2_t __attribute__((ext_vector_type(2)));

constexpr int TP = 16384, TS = 512, TT = 16896, DM = 1024, NCOL = 6656, SEQ = 8192;
constexpr int NPM = 66;
constexpr float EPS = 1e-6f;
constexpr size_t U1 = (size_t)TT * 1024 * 2;
constexpr size_t WT_IN = 0, WT_PM = WT_IN + (size_t)NCOL * 1024 * 2, WT_PP = WT_PM + 4 * 65536 * 2, WT_PA = WT_PP + 1048576 * 2,
                 WT_WO = WT_PA + 1048576 * 2, WT_PLE = WT_WO + 1048576 * 2, WT_WG = WT_PLE + 262144 * 2, WT_LAYER = WT_WG + 1048576 * 2;
constexpr size_t OFF_WT = 0, OFF_SA = OFF_WT + 2 * WT_LAYER, OFF_SB = OFF_SA + U1, OFF_SC = OFF_SB + U1, OFF_SD = OFF_SC + U1,
                 OFF_SE = OFF_SD + U1, OFF_SF = OFF_SE + U1, OFF_PART = OFF_SF + U1, OFF_ROPE = OFF_PART + (size_t)TT * 32 * 4,
                 OFF_YAS = OFF_ROPE + (size_t)8196 * 16 * 4, OFF_BAR = OFF_YAS + (size_t)TS * 1024 * 2, WS_NEED = OFF_BAR + 3 * (3456 + 64) * 4;
constexpr size_t PANEL = (size_t)TT * 256 * 2;
constexpr size_t O_Y = 0, O_KP = 17301504, O_VP = O_KP + 131072, O_PP = O_VP + 131072, O_KS = O_PP + 61440, O_VS = O_KS + 8388608,
                 O_PS = O_VS + 8388608;

struct Params {
    const float *x_prompt, *x_sample, *cache_k, *cache_v, *state_pool, *p_prompt, *p_sample, *norm_g, *w_in, *q_norm_g, *k_norm_g, *sinks,
        *pool_map, *pool_scale, *w_proj_pool, *w_proj_attn, *w_out, *w_ple, *w_ple_gate;
    float* out;
    unsigned char* ws;
    float inv_freq[8];
};

typedef const __attribute__((address_space(4))) Params CParams;
DI unsigned pk2(float a, float b) { f32x2 v = {a, b}; bf2_t r = __builtin_convertvector(v, bf2_t); return __builtin_bit_cast(unsigned, r); }
DI float bflo(unsigned u) { return __uint_as_float(u << 16); }
DI float bfhi(unsigned u) { return __uint_as_float(u & 0xffff0000u); }
DI float bf1(bf16_t u) { return __uint_as_float(((unsigned)u) << 16); }
DI float sigmoidf_(float v) { return __builtin_amdgcn_rcpf(1.f + __expf(-v)); }
DI float siluf_(float v) { return v * sigmoidf_(v); }
DI u32x2 pk4(f32x4 v) { u32x2 r; r.x = pk2(v[0], v[1]); r.y = pk2(v[2], v[3]); return r; }
DI f32x4 unpk4(u32x2 u) { f32x4 r; r[0] = bflo(u.x); r[1] = bfhi(u.x); r[2] = bflo(u.y); r[3] = bfhi(u.y); return r; }

DI int bidx() { int b = blockIdx.x; asm volatile("" : "+s"(b)); return b; }
DI int tidx() { int t = threadIdx.x; asm volatile("" : "+v"(t)); return t; }
template <class P> DI P* launder(P* q) { asm volatile("" : "+s"(q)); return q; }
constexpr int BM = 256, BK = 64, HALF = 128, HTB = HALF * BK * 2, STAGE_BYTES = 8 * HTB, NXCD = 8, WGM = 8;
DI int lds_byte(int r, int c) { const int st = (r >> 4) * 2 + (c >> 5), rr = r & 15, cc = c & 31, ob = rr * 64 + cc * 2; return st * 1024 + (ob ^ (((ob >> 9) & 1) << 5)); }
DI void stage_rc(int b, int& R, int& C) { const int st = b / 1024, sb = b % 1024, swz = sb ^ (((sb >> 9) & 1) << 5); R = (st >> 1) * 16 + swz / 64; C = (st & 1) * 32 + (swz % 64) / 2; }

struct Unit { const char* A; const char* B; unsigned lda, ldb; int nt, pm, pn, kind, idx; };
struct TileOrder {
    int nM, nN, nwg, nx;
    DI void init(int nM_, int nN_, int nx_ = 4) { nM = nM_; nN = nN_; nwg = nM_ * nN_; nx = nx_; }
    DI void map(int L, int& pm, int& pn) const {
        int wgid = L; { const int q = nwg / nx, r = nwg % nx, xcd = wgid % nx, off = wgid / nx; wgid = (xcd < r ? xcd * (q + 1) : r * (q + 1) + (xcd - r) * q) + off; }
        const int nig = WGM * nN, gid = wgid / nig, fm = gid * WGM, gsz = (nM - fm) < WGM ? (nM - fm) : WGM;
        pm = fm + ((wgid % nig) % gsz); pn = (wgid % nig) / gsz;
    }
};

typedef f32x4 Acc[2][2][4][2];

template <class Epi, class Sched>
DI void gemm_phase(LAS unsigned char* lds, const Sched& S, const Epi& E) {
    const int tid = tidx(), wid = __builtin_amdgcn_readfirstlane(tid >> 6), lane = tid & 63, wr = wid >> 2, wc = wid & 3, fr = lane & 15, fq = lane >> 4;
    int R0, C0, R1, C1; stage_rc(tid * 16, R0, C0); stage_rc(tid * 16 + 8192, R1, C1);
    const size_t kstep = (size_t)(BK * 2);
    const unsigned ldsw = (unsigned)wid * 1024u;
    const int aoff = lds_byte(wr * 64 + fr, fq * 8), boff = lds_byte(wc * 32 + fr, fq * 8);
#define G_SA(b, h) (((b) * 2 + (h)) * HTB)
#define G_SB(b, h) ((4 + (b) * 2 + (h)) * HTB)
#define G_STAGE(bufoff, gbase, v0, v1) do { \
        __builtin_amdgcn_global_load_lds((const unsigned*)((const char*)(gbase) + (v0)), (LAS unsigned*)(lds + (bufoff) + ldsw), 16, 0, 0); \
        __builtin_amdgcn_global_load_lds((const unsigned*)((const char*)(gbase) + (v1)), (LAS unsigned*)(lds + (bufoff) + ldsw + 8192), 16, 0, 0); } while (0)
#define G_LDA(dst, b, h) do { _Pragma("unroll") for (int m = 0; m < 4; ++m) _Pragma("unroll") for (int k = 0; k < 2; ++k) dst[m][k] = *(const LAS bf16x8*)(lds + G_SA(b, h) + aoff + m * 2048 + k * 1024); } while (0)
#define G_LDB(dst, b, h) do { _Pragma("unroll") for (int n = 0; n < 2; ++n) _Pragma("unroll") for (int k = 0; k < 2; ++k) dst[n][k] = *(const LAS bf16x8*)(lds + G_SB(b, h) + boff + n * 2048 + k * 1024); } while (0)
#define G_MMA(ai, bj, At, Bt) do { __builtin_amdgcn_s_setprio(1); _Pragma("unroll") for (int m = 0; m < 4; ++m) _Pragma("unroll") for (int n = 0; n < 2; ++n) _Pragma("unroll") for (int k = 0; k < 2; ++k) \
        acc[ai][bj][m][n] = __builtin_amdgcn_mfma_f32_16x16x32_bf16(Bt[n][k], At[m][k], acc[ai][bj][m][n], 0, 0, 0); __builtin_amdgcn_s_setprio(0); } while (0)
#define G_WAIT_V(n) asm volatile("s_waitcnt vmcnt(" #n ")" ::: "memory")
#define G_WAIT_L(n) asm volatile("s_waitcnt lgkmcnt(" #n ")" ::: "memory")
#define G_BAR __builtin_amdgcn_s_barrier()
#define G_SCHED __builtin_amdgcn_sched_barrier(0)
    Unit cur, nxt; int ui = 0;
    if (!S.next(0, cur)) return;
    Acc acc;
#pragma unroll
    for (int a = 0; a < 2; ++a)
#pragma unroll
        for (int b = 0; b < 2; ++b)
#pragma unroll
            for (int m = 0; m < 4; ++m)
#pragma unroll
                for (int n = 0; n < 2; ++n) acc[a][b][m][n] = (f32x4){0.f, 0.f, 0.f, 0.f};
    bf16x8 At[4][2], B0[2][2], B1[2][2];
    const char* cA = cur.A; const char* cB = cur.B;
    unsigned lda = cur.lda, ldb = cur.ldb;
    const unsigned C0b = C0 * 2, C1b = C1 * 2;
#define G_VO(R, Cb, ld) ((unsigned)(R) * (ld) + (Cb))
    unsigned vA0 = G_VO(R0, C0b, lda), vA1 = G_VO(R1, C1b, lda), vB0 = G_VO(R0, C0b, ldb), vB1 = G_VO(R1, C1b, ldb);
#define G_STA(bufoff, gbase, ld) do { if constexpr (Sched::VAR) G_STAGE(bufoff, gbase, G_VO(R0, C0b, ld), G_VO(R1, C1b, ld)); else G_STAGE(bufoff, gbase, vA0, vA1); } while (0)
#define G_STB(bufoff, gbase, ld) do { if constexpr (Sched::VAR) G_STAGE(bufoff, gbase, G_VO(R0, C0b, ld), G_VO(R1, C1b, ld)); else G_STAGE(bufoff, gbase, vB0, vB1); } while (0)
    size_t hA = (size_t)HALF * lda, hB = (size_t)HALF * ldb;
    G_STB(G_SB(0, 0), cB, ldb); G_STB(G_SB(0, 1), cB + hB, ldb); G_STA(G_SA(0, 0), cA, lda); G_STA(G_SA(0, 1), cA + hA, lda);
    if (wr == 1) G_BAR;
    G_WAIT_V(2); G_BAR;
    G_STB(G_SB(1, 0), cB + kstep, ldb); G_STA(G_SA(1, 0), cA + kstep, lda); G_STB(G_SB(1, 1), cB + hB + kstep, ldb);
    G_WAIT_V(6); G_BAR;
    for (;;) {
        const bool has_next = S.next(ui + 1, nxt);
        const char* nA = has_next ? nxt.A : cA; const char* nB = has_next ? nxt.B : cB;
        unsigned nlda = lda, nldb = ldb; size_t nhA = hA, nhB = hB;
        if constexpr (Sched::VAR) { nlda = has_next ? nxt.lda : lda; nldb = has_next ? nxt.ldb : ldb; nhA = (size_t)HALF * nlda; nhB = (size_t)HALF * nldb; }
        const int nt = cur.nt;
#pragma unroll 1
        for (int t = 0; t < nt; t += 2) {
            const bool last = (t == nt - 2);
            const char* a1 = cA + (size_t)(t + 1) * kstep;
            const char* a2 = last ? nA : cA + (size_t)(t + 2) * kstep; const char* b2 = last ? nB : cB + (size_t)(t + 2) * kstep;
            const char* a3 = a2 + kstep; const char* b3 = b2 + kstep;
            const unsigned xlda = last ? nlda : lda, xldb = last ? nldb : ldb;
            const size_t xhA = last ? nhA : hA, xhB = last ? nhB : hB;
            G_LDB(B0, 0, 0); G_LDB(B1, 0, 1); G_SCHED; G_LDA(At, 0, 0); G_STA(G_SA(1, 1), a1 + hA, lda);
            G_WAIT_V(8); G_WAIT_L(0); G_BAR; G_MMA(0, 0, At, B0); G_MMA(0, 1, At, B1); G_BAR; G_SCHED;
            G_LDA(At, 0, 1); G_STB(G_SB(0, 0), b2, xldb); G_STB(G_SB(0, 1), b2 + xhB, xldb); G_STA(G_SA(0, 0), a2, xlda);
            G_WAIT_V(8); G_WAIT_L(0); G_BAR; G_MMA(1, 0, At, B0); G_MMA(1, 1, At, B1); G_BAR; G_SCHED;
            G_LDB(B0, 1, 0); G_LDB(B1, 1, 1); G_SCHED; G_LDA(At, 1, 0); G_STA(G_SA(0, 1), a2 + xhA, xlda);
            G_WAIT_V(8); G_WAIT_L(0); G_BAR; G_MMA(0, 0, At, B0); G_MMA(0, 1, At, B1); G_BAR; G_SCHED;
            G_LDA(At, 1, 1); G_STB(G_SB(1, 0), b3, xldb); G_STB(G_SB(1, 1), b3 + xhB, xldb); G_STA(G_SA(1, 0), a3, xlda);
            G_WAIT_V(8); G_WAIT_L(0); G_BAR; G_MMA(1, 0, At, B0); G_MMA(1, 1, At, B1); G_BAR; G_SCHED;
        }
        if (wr == 0) G_BAR;
        const bool keep = E(acc, cur, wr, wc, fr, fq);
        if (!has_next) break;
        if (!keep) {
#pragma unroll
            for (int a = 0; a < 2; ++a)
#pragma unroll
                for (int b = 0; b < 2; ++b)
#pragma unroll
                    for (int m = 0; m < 4; ++m)
#pragma unroll
                        for (int n = 0; n < 2; ++n) acc[a][b][m][n] = (f32x4){0.f, 0.f, 0.f, 0.f};
        }
        cur = nxt; cA = nA; cB = nB; lda = nlda; ldb = nldb; hA = nhA; hB = nhB; ++ui;
        if (wr == 1) G_BAR;
    }
    G_WAIT_V(0);
    G_BAR;
#undef G_SA
#undef G_SB
#undef G_STAGE
#undef G_STA
#undef G_STB
#undef G_VO
#undef G_LDA
#undef G_LDB
#undef G_MMA
#undef G_WAIT_V
#undef G_WAIT_L
#undef G_BAR
#undef G_SCHED
}

DI const char* wtp(CParams* p, int l, size_t off) { return (const char*)(p->ws + OFF_WT + (size_t)l * WT_LAYER + off); }
struct SchedZ { static constexpr bool VAR = false;
    TileOrder o; int G, c, mode, l, h; CParams* p;
    DI bool next(int i, Unit& u) const {
        const int L = i * G + c; if (L >= o.nwg) return false;
        int pm, j; o.map(L, pm, j); pm = pm < 32 ? 32 * h + pm : 64 + h;
        const int ct = mode == 0 ? (j < 5 ? j : j + 3) : (j < 3 ? 5 + j : 15 + j);
        u.A = (l == 0 ? (const char*)(p->ws + OFF_SA) : (const char*)p->out) + (size_t)pm * 256 * 2048; u.B = wtp(p, l, WT_IN) + (size_t)ct * 256 * 2048; u.lda = 2048; u.ldb = 2048; u.nt = 16; u.pm = pm; u.pn = ct; u.kind = 0; u.idx = i; return true;
    }
};
struct SchedPool { static constexpr bool VAR = false;
    TileOrder o; int G, c, l, h; CParams* p;
    DI bool next(int i, Unit& u) const {
        const int L = i * G + c; if (L >= o.nwg) return false;
        int pm, g; o.map(L, pm, g); pm += 32 * h;
        u.A = (const char*)(p->ws + OFF_SF) + (size_t)pm * 256 * 2048 + g * 512; u.B = wtp(p, l, WT_PM) + (size_t)g * 256 * 512; u.lda = 2048; u.ldb = 512; u.nt = 4; u.pm = pm; u.pn = g; u.kind = 0; return true;
    }
};
struct SchedMerge { static constexpr bool VAR = false;
    TileOrder o; int G, c, l, h; CParams* p;
    DI bool next(int i, Unit& u) const {
        const int L = (i >> 1) * G + c; if (L >= o.nwg) return false;
        int pm, pn; o.map(L, pm, pn); pm += 32 * h; const int seg = i & 1;
        u.A = (const char*)(p->ws + (seg ? OFF_SC : OFF_SF)) + (size_t)pm * 256 * 2048; u.B = wtp(p, l, seg ? WT_PA : WT_PP) + (size_t)pn * 256 * 2048; u.lda = 2048; u.ldb = 2048; u.nt = 16; u.pm = pm; u.pn = pn; u.kind = seg; return true;
    }
};
struct SchedRes1 { static constexpr bool VAR = true;
    TileOrder o; int G, c, l, h; CParams* p;
    DI bool next(int i, Unit& u) const {
        int L = i * G + c; if (L >= 2 * o.nwg) return false;
        const int kind = L >= o.nwg; if (kind) L -= o.nwg;
        int pm, pn; o.map(L, pm, pn); pm += 32 * h;
        if (!kind) { u.A = (const char*)(p->ws + OFF_SA) + (size_t)pm * 256 * 2048; u.B = wtp(p, l, WT_WO) + (size_t)pn * 256 * 2048; u.lda = 2048; u.ldb = 2048; u.nt = 16; }
        else { u.A = (const char*)(p->ws + OFF_SE) + (size_t)pm * 256 * 512; u.B = wtp(p, l, WT_PLE) + (size_t)pn * 256 * 512; u.lda = 512; u.ldb = 512; u.nt = 4; }
        u.pm = pm; u.pn = pn; u.kind = kind; return true;
    }
};
struct SchedPlain { static constexpr bool VAR = false;
    TileOrder o; int G, c, l, h; CParams* p;
    DI bool next(int i, Unit& u) const {
        const int L = i * G + c; if (L >= o.nwg) return false;
        int pm, pn; o.map(L, pm, pn); pm += 32 * h;
        u.A = (const char*)(p->ws + OFF_SC) + (size_t)pm * 256 * 2048; u.B = wtp(p, l, WT_WG) + (size_t)pn * 256 * 2048; u.lda = 2048; u.ldb = 2048; u.nt = 16; u.pm = pm; u.pn = pn; u.kind = 0; return true;
    }
};

DI float rstd_row(const float* part, int row) {
    const f32x4* q = (const f32x4*)(part + (size_t)row * 32);
    f32x4 t = q[0];
#pragma unroll
    for (int i = 1; i < 8; ++i) t += q[i];
    const float s = (t[0] + t[1]) + (t[2] + t[3]);
    return __builtin_amdgcn_rsqf(s * (1.f / 1024.f) + EPS);
}
DI u32x4 pk8(f32x4 a, f32x4 b) { u32x4 r; r[0] = pk2(a[0], a[1]); r[1] = pk2(a[2], a[3]); r[2] = pk2(b[0], b[1]); r[3] = pk2(b[2], b[3]); return r; }
DI void unpk8(u32x4 u, f32x4& a, f32x4& b) { a[0] = bflo(u[0]); a[1] = bfhi(u[0]); a[2] = bflo(u[1]); a[3] = bfhi(u[1]); b[0] = bflo(u[2]); b[1] = bfhi(u[2]); b[2] = bflo(u[3]); b[3] = bfhi(u[3]); }

template <class Sched>
DI void rstd_table(const Sched& S, const float* part, LAS float* rs) {
    const int tid = tidx();
    Unit u;
    for (int i = 0; i < 8 && S.next(i, u); ++i)
        if (tid < 256) rs[i * 256 + tid] = rstd_row(part, u.pm * 256 + tid);
    __syncthreads();
}
struct EpiZ {
    int l; CParams* p; const LAS float* rs;
    DI bool operator()(Acc& acc, const Unit& u, int wr, int wc, int fr, int fq) const {
        unsigned char* ws = p->ws; float* out = p->out;
        const int ct = u.pn, row0 = u.pm * 256 + wr * 64 + fr, cl0 = wc * 64 + 16 * fq;
        if (ct < 4) {
            const bool special = (u.pm == 31) | (u.pm >= 63);
#pragma unroll
            for (int ai = 0; ai < 2; ++ai)
#pragma unroll
                for (int m = 0; m < 4; ++m) {
                    const int row = row0 + ai * 128 + m * 16; const float rsv = u.idx < 8 ? rs[u.idx * 256 + (row & 255)] : rstd_row((const float*)(ws + OFF_PART), row);
                    float* po = nullptr;
                    if (special) {
                        if (row >= TP) { const int sb = (row - TP) >> 2, i = row & 3; po = out + O_PS + ((size_t)(l * 128 + sb) * 15 + 11 + i) * 1024; }
                        else { const int t = row & (SEQ - 1), b = row >> 13; if (t >= SEQ - 15) po = out + O_PP + ((size_t)(l * 2 + b) * 15 + (t - (SEQ - 15))) * 1024; }
                    }
#pragma unroll
                    for (int bj = 0; bj < 2; ++bj) {
                        const int col = ct * 256 + cl0 + 8 * bj;
                        const f32x4 v0 = acc[ai][bj][m][0] * rsv, v1 = acc[ai][bj][m][1] * rsv;
                        *(u32x4*)((bf16_t*)(ws + OFF_SB) + (size_t)row * 1024 + col) = pk8(v0, v1);
                        if (po) { *(f32x4*)(po + col) = v0; *(f32x4*)(po + col + 4) = v1; }
                    }
                }
        } else if (ct >= 18) {
            bf16_t* RB = (bf16_t*)(ws + OFF_SB); bf16_t* GB = (bf16_t*)(ws + OFF_SD);
#pragma unroll
            for (int ai = 0; ai < 2; ++ai)
#pragma unroll
                for (int m = 0; m < 4; ++m) {
                    __builtin_amdgcn_sched_barrier(0);
                    const int row = row0 + ai * 128 + m * 16; const float rsv = u.idx < 8 ? rs[u.idx * 256 + (row & 255)] : rstd_row((const float*)(ws + OFF_PART), row);
                    const size_t off = (size_t)row * 1024 + (ct - 18) * 128 + wc * 32 + 8 * fq;
                    f32x4 r[2], g[2];
#pragma unroll
                    for (int n = 0; n < 2; ++n) {
                        const f32x4 xa = acc[ai][0][m][n] * rsv, xb = acc[ai][1][m][n] * rsv;
#pragma unroll
                        for (int j = 0; j < 4; ++j) { const float ea = 1.f + __expf(-xa[j]), eb = 1.f + __expf(-xb[j]); r[n][j] = eb * __builtin_amdgcn_rcpf(ea); g[n][j] = __builtin_amdgcn_rcpf(eb); }
                    }
                    *(u32x4*)(RB + off) = pk8(r[0], r[1]);
                    *(u32x4*)(GB + off) = pk8(g[0], g[1]);
                }
        } else if (ct < 8 || (ct >= 14)) {
            bf16_t* dst; int ld, cbase; bool silu;
            if (ct < 8) { dst = (bf16_t*)(ws + OFF_SE) + (size_t)(ct - 4) * ((size_t)TT * 256); ld = 256; cbase = 0; silu = true; }
            else { dst = (bf16_t*)(ws + OFF_SD); ld = 1024; cbase = (ct - 14) * 256; silu = true; }
#pragma unroll
            for (int ai = 0; ai < 2; ++ai)
#pragma unroll
                for (int m = 0; m < 4; ++m) {
                    const int row = row0 + ai * 128 + m * 16; const float rsv = u.idx < 8 ? rs[u.idx * 256 + (row & 255)] : rstd_row((const float*)(ws + OFF_PART), row);
#pragma unroll
                    for (int bj = 0; bj < 2; ++bj) {
                        const int col = cbase + cl0 + 8 * bj;
                        f32x4 v0 = acc[ai][bj][m][0] * rsv, v1 = acc[ai][bj][m][1] * rsv;
#pragma unroll
                        for (int j = 0; j < 4; ++j) { const float s0 = sigmoidf_(v0[j]), s1 = sigmoidf_(v1[j]); v0[j] = silu ? v0[j] * s0 : s0; v1[j] = silu ? v1[j] * s1 : s1; }
                        *(u32x4*)(dst + (size_t)row * ld + col) = pk8(v0, v1);
                    }
                }
        } else if (ct < 13) {
            const bool isk = ct == 12;
            const float* gw = (isk ? p->k_norm_g : p->q_norm_g) + l * 64; const float* rope = (const float*)(ws + OFF_ROPE);
            f32x4 gv[2][2];
#pragma unroll
            for (int bj = 0; bj < 2; ++bj)
#pragma unroll
                for (int n = 0; n < 2; ++n) gv[bj][n] = *(const f32x4*)(gw + 16 * fq + 8 * bj + 4 * n);
            const float osc = isk ? 1.f : 0.125f;
            const int head = isk ? wc : (ct - 8) * 4 + wc;
#pragma unroll
            for (int ai = 0; ai < 2; ++ai)
#pragma unroll
                for (int m = 0; m < 4; ++m) {
                    const int row = row0 + ai * 128 + m * 16; const float rsv = u.idx < 8 ? rs[u.idx * 256 + (row & 255)] : rstd_row((const float*)(ws + OFF_PART), row);
                    f32x4 v[2][2]; float ss = 0.f;
#pragma unroll
                    for (int bj = 0; bj < 2; ++bj)
#pragma unroll
                        for (int n = 0; n < 2; ++n) { v[bj][n] = acc[ai][bj][m][n] * rsv;
#pragma unroll
                            for (int j = 0; j < 4; ++j) ss += v[bj][n][j] * v[bj][n][j]; }
                    ss += __shfl_xor(ss, 16); ss += __shfl_xor(ss, 32);
                    const float rn = __builtin_amdgcn_rsqf(ss * (1.f / 64.f) + EPS);
#pragma unroll
                    for (int bj = 0; bj < 2; ++bj)
#pragma unroll
                        for (int n = 0; n < 2; ++n) v[bj][n] = v[bj][n] * rn * gv[bj][n];
                    if (fq == 0) {
                        const int pidx = row < TP ? (row & (SEQ - 1)) : SEQ + (row & 3);
                        const f32x4* rp = (const f32x4*)(rope + (size_t)pidx * 16);
                        const f32x4 c0 = rp[0], c1 = rp[1], s0 = rp[2], s1 = rp[3];
                        const f32x4 a0 = v[0][0], a1 = v[0][1], b0 = v[1][0], b1 = v[1][1];
                        v[0][0] = a0 * c0 - b0 * s0; v[0][1] = a1 * c1 - b1 * s1;
                        v[1][0] = b0 * c0 + a0 * s0; v[1][1] = b1 * c1 + a1 * s1;
                    }
                    float* po = nullptr;
                    if (isk) {
                        if (row >= TP) { const int sb = (row - TP) >> 2, i = row & 3; po = out + O_KS + (((size_t)(l * 128 + sb) * 128 + 124 + i) * 4 + wc) * 64; }
                        else { const int t = row & (SEQ - 1), b = row >> 13; if (t >= SEQ - 128) po = out + O_KP + (((size_t)(l * 2 + b) * 128 + (t - (SEQ - 128))) * 4 + wc) * 64; }
                    }
                    bf16_t* dst = isk ? (bf16_t*)(ws + OFF_SE + 2 * PANEL) + (size_t)row * 256 + wc * 64 : (bf16_t*)(ws + OFF_SC) + (size_t)row * 1024 + head * 64;
#pragma unroll
                    for (int bj = 0; bj < 2; ++bj) {
                        const int d = 16 * fq + 8 * bj;
                        if (po) { *(f32x4*)(po + d) = v[bj][0]; *(f32x4*)(po + d + 4) = v[bj][1]; }
                        *(u32x4*)(dst + d) = pk8(v[bj][0] * osc, v[bj][1] * osc);
                    }
                }
        } else {
#pragma unroll
            for (int ai = 0; ai < 2; ++ai)
#pragma unroll
                for (int m = 0; m < 4; ++m) {
                    const int row = row0 + ai * 128 + m * 16; const float rsv = u.idx < 8 ? rs[u.idx * 256 + (row & 255)] : rstd_row((const float*)(ws + OFF_PART), row);
                    float* po = nullptr;
                    if (row >= TP) { const int sb = (row - TP) >> 2, i = row & 3; po = out + O_VS + ((size_t)(l * 128 + sb) * 128 + 124 + i) * 256; }
                    else { const int t = row & (SEQ - 1), b = row >> 13; if (t >= SEQ - 128) po = out + O_VP + ((size_t)(l * 2 + b) * 128 + (t - (SEQ - 128))) * 256; }
#pragma unroll
                    for (int bj = 0; bj < 2; ++bj) {
                        const int col = cl0 + 8 * bj;
                        const f32x4 v0 = acc[ai][bj][m][0] * rsv, v1 = acc[ai][bj][m][1] * rsv;
                        if (po) { *(f32x4*)(po + col) = v0; *(f32x4*)(po + col + 4) = v1; }
                        *(u32x4*)((bf16_t*)(ws + OFF_SE + 3 * PANEL) + (size_t)row * 256 + col) = pk8(v0, v1);
                    }
                }
        }
        return false;
    }
};

struct EpiPool {
    int l; CParams* p;
    DI bool operator()(Acc& acc, const Unit& u, int wr, int wc, int fr, int fq) const {
        const float* scale = p->pool_scale + l * 1024; const bf16_t* SZP = (const bf16_t*)(p->ws + OFF_SE); bf16_t* YA = (bf16_t*)(p->ws + OFF_SF);
        const int g = u.pn, row0 = u.pm * 256 + wr * 64 + fr, cl0 = wc * 64 + 16 * fq;
        const bf16_t* zp = SZP + (size_t)g * ((size_t)TT * 256);
        f32x4 sc[2][2];
#pragma unroll
        for (int bj = 0; bj < 2; ++bj)
#pragma unroll
            for (int n = 0; n < 2; ++n) sc[bj][n] = *(const f32x4*)(scale + g * 256 + cl0 + 8 * bj + 4 * n);
#pragma unroll
        for (int ai = 0; ai < 2; ++ai)
#pragma unroll
            for (int m = 0; m < 4; ++m) {
                const int row = row0 + ai * 128 + m * 16;
#pragma unroll
                for (int bj = 0; bj < 2; ++bj) {
                    const int cl = cl0 + 8 * bj;
                    f32x4 z0, z1; unpk8(*(const u32x4*)(zp + (size_t)row * 256 + cl), z0, z1);
                    *(u32x4*)(YA + (size_t)row * 1024 + g * 256 + cl) = pk8(acc[ai][bj][m][0] * sc[bj][0] * z0, acc[ai][bj][m][1] * sc[bj][1] * z1);
                }
            }
        return false;
    }
};

struct EpiMerge {
    CParams* p;
    DI bool operator()(Acc& acc, const Unit& u, int wr, int wc, int fr, int fq) const {
        const int row0 = u.pm * 256 + wr * 64 + fr, c0 = u.pn * 256 + wc * 64 + 16 * fq;
        const bf16_t* G = (const bf16_t*)(p->ws + (u.kind == 0 ? OFF_SB : OFF_SD)) + (size_t)row0 * 1024 + c0; bf16_t* M = (bf16_t*)(p->ws + OFF_SA) + (size_t)row0 * 1024 + c0;
        u32x4 buf[2][4];
#pragma unroll
        for (int st = 0; st <= 4; ++st) {
            if (st < 4) {
#pragma unroll
                for (int mm = 0; mm < 2; ++mm)
#pragma unroll
                    for (int bj = 0; bj < 2; ++bj) buf[st & 1][mm * 2 + bj] = *(const u32x4*)(G + (size_t)((st >> 1) * 128 + ((st & 1) * 2 + mm) * 16) * 1024 + 8 * bj);
            }
            __builtin_amdgcn_sched_barrier(0);
            if (st > 0) {
                const int q = st - 1, ai = q >> 1;
#pragma unroll
                for (int mm = 0; mm < 2; ++mm)
#pragma unroll
                    for (int bj = 0; bj < 2; ++bj) {
                        const int m = (q & 1) * 2 + mm;
                        f32x4 g0, g1; unpk8(buf[q & 1][mm * 2 + bj], g0, g1);
                        if (u.kind == 0) { acc[ai][bj][m][0] *= g0; acc[ai][bj][m][1] *= g1; }
                        else *(u32x4*)(M + (size_t)(ai * 128 + m * 16) * 1024 + 8 * bj) = pk8(acc[ai][bj][m][0] * g0, acc[ai][bj][m][1] * g1);
                    }
                __builtin_amdgcn_sched_barrier(0);
            }
        }
        return u.kind == 0;
    }
};

struct EpiRes1 {
    int l; CParams* p;
    DI bool operator()(Acc& acc, const Unit& u, int wr, int wc, int fr, int fq) const {
        const int row0 = u.pm * 256 + wr * 64 + fr, c0 = u.pn * 256 + wc * 64 + 16 * fq;
        if (u.kind != 0) {
            bf16_t* E = (bf16_t*)(p->ws + OFF_SB) + (size_t)row0 * 1024 + c0;
#pragma unroll
            for (int ai = 0; ai < 2; ++ai)
#pragma unroll
                for (int m = 0; m < 4; ++m)
#pragma unroll
                    for (int bj = 0; bj < 2; ++bj) *(u32x4*)(E + (size_t)(ai * 128 + m * 16) * 1024 + 8 * bj) = pk8(acc[ai][bj][m][0], acc[ai][bj][m][1]);
            return false;
        }
        bf16_t* H1B = (bf16_t*)(p->ws + OFF_SC) + (size_t)row0 * 1024 + c0;
        if (l == 0) {
            const float* hin = (row0 < TP ? p->x_prompt + (size_t)row0 * 1024 : p->x_sample + (size_t)(row0 - TP) * 1024) + c0;
            f32x4 buf[2][8];
#pragma unroll
            for (int st = 0; st <= 4; ++st) {
                if (st < 4) {
#pragma unroll
                    for (int mm = 0; mm < 2; ++mm)
#pragma unroll
                        for (int bj = 0; bj < 2; ++bj) { const float* q = hin + (size_t)((st >> 1) * 128 + ((st & 1) * 2 + mm) * 16) * 1024 + 8 * bj; buf[st & 1][(mm * 2 + bj) * 2] = *(const f32x4*)q; buf[st & 1][(mm * 2 + bj) * 2 + 1] = *(const f32x4*)(q + 4); }
                }
                __builtin_amdgcn_sched_barrier(0);
                if (st > 0) {
                    const int q = st - 1, ai = q >> 1;
#pragma unroll
                    for (int mm = 0; mm < 2; ++mm)
#pragma unroll
                        for (int bj = 0; bj < 2; ++bj) { const int m = (q & 1) * 2 + mm;
                            *(u32x4*)(H1B + (size_t)(ai * 128 + m * 16) * 1024 + 8 * bj) = pk8(buf[q & 1][(mm * 2 + bj) * 2] + acc[ai][bj][m][0], buf[q & 1][(mm * 2 + bj) * 2 + 1] + acc[ai][bj][m][1]); }
                    __builtin_amdgcn_sched_barrier(0);
                }
            }
        } else {
            const bf16_t* HB = (const bf16_t*)p->out + (size_t)row0 * 1024 + c0;
            u32x4 buf[2][4];
#pragma unroll
            for (int st = 0; st <= 4; ++st) {
                if (st < 4) {
#pragma unroll
                    for (int mm = 0; mm < 2; ++mm)
#pragma unroll
                        for (int bj = 0; bj < 2; ++bj) buf[st & 1][mm * 2 + bj] = *(const u32x4*)(HB + (size_t)((st >> 1) * 128 + ((st & 1) * 2 + mm) * 16) * 1024 + 8 * bj);
                }
                __builtin_amdgcn_sched_barrier(0);
                if (st > 0) {
                    const int q = st - 1, ai = q >> 1;
#pragma unroll
                    for (int mm = 0; mm < 2; ++mm)
#pragma unroll
                        for (int bj = 0; bj < 2; ++bj) { const int m = (q & 1) * 2 + mm; f32x4 h0, h1; unpk8(buf[q & 1][mm * 2 + bj], h0, h1);
                            *(u32x4*)(H1B + (size_t)(ai * 128 + m * 16) * 1024 + 8 * bj) = pk8(h0 + acc[ai][bj][m][0], h1 + acc[ai][bj][m][1]); }
                    __builtin_amdgcn_sched_barrier(0);
                }
            }
        }
        return false;
    }
};

struct EpiRes2 {
    int l; CParams* p;
    DI bool operator()(Acc& acc, const Unit& u, int wr, int wc, int fr, int fq) const {
        const int row0 = u.pm * 256 + wr * 64 + fr, c0 = u.pn * 256 + wc * 64 + 16 * fq;
        const size_t o0_ = (size_t)row0 * 1024 + c0;
        float* y = p->out + O_Y + o0_; bf16_t* HB = (bf16_t*)p->out + o0_; const bf16_t* H1B = (const bf16_t*)(p->ws + OFF_SC) + o0_; const bf16_t* E = (const bf16_t*)(p->ws + OFF_SB) + o0_;
        float* part = (float*)(p->ws + OFF_PART) + (size_t)row0 * 32 + u.pn * 8 + wc * 2;
        u32x4 bh[2][4], be[2][4];
#pragma unroll
        for (int st = 0; st <= 4; ++st) {
            if (st < 4) {
#pragma unroll
                for (int mm = 0; mm < 2; ++mm)
#pragma unroll
                    for (int bj = 0; bj < 2; ++bj) { const size_t o = (size_t)((st >> 1) * 128 + ((st & 1) * 2 + mm) * 16) * 1024 + 8 * bj; bh[st & 1][mm * 2 + bj] = *(const u32x4*)(H1B + o); be[st & 1][mm * 2 + bj] = *(const u32x4*)(E + o); }
            }
            __builtin_amdgcn_sched_barrier(0);
            if (st > 0) {
                const int q = st - 1, ai = q >> 1;
#pragma unroll
                for (int mm = 0; mm < 2; ++mm) {
                    const int m = (q & 1) * 2 + mm;
                    float ssb[2];
#pragma unroll
                    for (int bj = 0; bj < 2; ++bj) {
                        float ss = 0.f;
                        const size_t o = (size_t)(ai * 128 + m * 16) * 1024 + 8 * bj;
                        f32x4 h0, h1, e0, e1; unpk8(bh[q & 1][mm * 2 + bj], h0, h1); unpk8(be[q & 1][mm * 2 + bj], e0, e1);
                        f32x4 o0, o1;
#pragma unroll
                        for (int j = 0; j < 4; ++j) { o0[j] = h0[j] + sigmoidf_(acc[ai][bj][m][0][j]) * e0[j]; o1[j] = h1[j] + sigmoidf_(acc[ai][bj][m][1][j]) * e1[j]; ss += o0[j] * o0[j] + o1[j] * o1[j]; }
                        if (l == 0) *(u32x4*)(HB + o) = pk8(o0, o1);
                        else { *(f32x4*)(y + o) = o0; *(f32x4*)(y + o + 4) = o1; }
                        ss += __shfl_xor(ss, 16); ss += __shfl_xor(ss, 32);
                        ssb[bj] = ss;
                    }
                    if (fq == 0) *(f32x2*)(part + (size_t)(ai * 128 + m * 16) * 32) = (f32x2){ssb[0], ssb[1]};
                }
                __builtin_amdgcn_sched_barrier(0);
            }
        }
        return false;
    }
};

struct MiniTile { int row0, pn, bj, wc; };
DI MiniTile mini_tile(int mt, int h) { MiniTile t; t.row0 = TP + 256 * h + 64 * (mt & 3); const int cg = mt >> 2; t.pn = cg >> 3; t.bj = (cg >> 2) & 1; t.wc = cg & 3; return t; }
template <int KSTEPS  >
DI void mini_partial(LAS float* red, const bf16_t* A, int lda, const bf16_t* Bt, int ldb, int tid) {
    const int wid = tid >> 6, lane = tid & 63, fr = lane & 15, fq = lane >> 4;
    const int k0 = wid * (32 * KSTEPS) + 8 * fq;
    bf16x8 af[KSTEPS][4], bfr[KSTEPS][2];
#pragma unroll
    for (int s = 0; s < KSTEPS; ++s) {
#pragma unroll
        for (int m = 0; m < 4; ++m) af[s][m] = *(const bf16x8*)(A + (size_t)(16 * m + fr) * lda + k0 + 32 * s);
#pragma unroll
        for (int n = 0; n < 2; ++n) bfr[s][n] = *(const bf16x8*)(Bt + (size_t)(16 * n + fr) * ldb + k0 + 32 * s);
    }
    f32x4 acc[4][2];
#pragma unroll
    for (int m = 0; m < 4; ++m)
#pragma unroll
        for (int n = 0; n < 2; ++n) acc[m][n] = (f32x4){0.f, 0.f, 0.f, 0.f};
#pragma unroll
    for (int s = 0; s < KSTEPS; ++s)
#pragma unroll
        for (int m = 0; m < 4; ++m)
#pragma unroll
            for (int n = 0; n < 2; ++n) acc[m][n] = __builtin_amdgcn_mfma_f32_16x16x32_bf16(bfr[s][n], af[s][m], acc[m][n], 0, 0, 0);
    LAS float* mine = red + wid * 2048;
#pragma unroll
    for (int m = 0; m < 4; ++m)
#pragma unroll
        for (int n = 0; n < 2; ++n) *(LAS f32x4*)(mine + (16 * m + fr) * 32 + 16 * n + 4 * fq) = acc[m][n];
}
DI f32x4 mini_sum(const LAS float* red, int tid) {
    f32x4 s = *(const LAS f32x4*)(red + tid * 4);
#pragma unroll
    for (int w = 1; w < 8; ++w) s += *(const LAS f32x4*)(red + w * 2048 + tid * 4);
    return s;
}
DI void mini_phase(CParams& p, int l, int kind, int c, int G, int h, LAS unsigned char* lds) {
    LAS float* red0 = (LAS float*)lds; LAS float* red1 = red0 + 16384;
    unsigned char* ws = p.ws;
    const unsigned char* wt = ws + OFF_WT + (size_t)l * WT_LAYER;
    for (int mt = c; mt < 128; mt += G) {
        const int tid = tidx();
        const MiniTile t = mini_tile(mt, h);
        const int srow = 128 * t.bj + 32 * t.wc;
        const int row = t.row0 + (tid >> 3), sq = tid & 7;
        const int col = t.pn * 256 + 64 * t.wc + 16 * (sq & 3) + 8 * t.bj + 4 * (sq >> 2);
        __syncthreads();
        if (kind == 3) {
            const bf16_t* A = (const bf16_t*)(ws + OFF_SF) + (size_t)t.row0 * 1024 + t.pn * 256;
            const bf16_t* B = (const bf16_t*)(wt + WT_PM) + (size_t)(t.pn * 256 + srow) * 256;
            mini_partial<1>(red0, A, 1024, B, 256, tid);
            __syncthreads();
            const f32x4 v = mini_sum(red0, tid);
            const f32x4 sc = *(const f32x4*)(p.pool_scale + l * 1024 + col);
            const f32x4 z = unpk4(*(const u32x2*)((const bf16_t*)(ws + OFF_SE) + (size_t)t.pn * ((size_t)TT * 256) + (size_t)row * 256 + (col & 255)));
            *(u32x2*)((bf16_t*)(ws + OFF_YAS) + (size_t)(row - TP) * 1024 + col) = pk4(v * sc * z);
        } else if (kind == 4) {
            mini_partial<4>(red0, (const bf16_t*)(ws + OFF_YAS) + (size_t)(t.row0 - TP) * 1024, 1024, (const bf16_t*)(wt + WT_PP) + (size_t)(t.pn * 256 + srow) * 1024, 1024, tid);
            mini_partial<4>(red1, (const bf16_t*)(ws + OFF_SC) + (size_t)t.row0 * 1024, 1024, (const bf16_t*)(wt + WT_PA) + (size_t)(t.pn * 256 + srow) * 1024, 1024, tid);
            __syncthreads();
            const f32x4 a = mini_sum(red0, tid), b = mini_sum(red1, tid);
            const size_t off = (size_t)row * 1024 + col;
            const f32x4 ga = unpk4(*(const u32x2*)((const bf16_t*)(ws + OFF_SB) + off)), gb = unpk4(*(const u32x2*)((const bf16_t*)(ws + OFF_SD) + off));
            *(u32x2*)((bf16_t*)(ws + OFF_SA) + off) = pk4(gb * (ga * a + b));
        } else if (kind == 5) {
            mini_partial<4>(red0, (const bf16_t*)(ws + OFF_SA) + (size_t)t.row0 * 1024, 1024, (const bf16_t*)(wt + WT_WO) + (size_t)(t.pn * 256 + srow) * 1024, 1024, tid);
            mini_partial<1>(red1, (const bf16_t*)(ws + OFF_SE) + (size_t)t.row0 * 256, 256, (const bf16_t*)(wt + WT_PLE) + (size_t)(t.pn * 256 + srow) * 256, 256, tid);
            __syncthreads();
            const f32x4 a = mini_sum(red0, tid), e = mini_sum(red1, tid);
            const size_t off = (size_t)row * 1024 + col;
            const f32x4 hin = l == 0 ? *(const f32x4*)(p.x_sample + (size_t)(row - TP) * 1024 + col) : unpk4(*(const u32x2*)((const bf16_t*)p.out + off));
            const f32x4 h1 = hin + a;
            *(u32x2*)((bf16_t*)(ws + OFF_SC) + off) = pk4(h1);
            *(u32x2*)((bf16_t*)(ws + OFF_SB) + off) = pk4(e);
        } else {
            mini_partial<4>(red0, (const bf16_t*)(ws + OFF_SC) + (size_t)t.row0 * 1024, 1024, (const bf16_t*)(wt + WT_WG) + (size_t)(t.pn * 256 + srow) * 1024, 1024, tid);
            __syncthreads();
            const f32x4 a = mini_sum(red0, tid);
            const size_t off = (size_t)row * 1024 + col;
            const f32x4 h1 = unpk4(*(const u32x2*)((const bf16_t*)(ws + OFF_SC) + off));
            const f32x4 e = unpk4(*(const u32x2*)((const bf16_t*)(ws + OFF_SB) + off));
            f32x4 h2; float ss = 0.f;
#pragma unroll
            for (int j = 0; j < 4; ++j) { h2[j] = h1[j] + sigmoidf_(a[j]) * e[j]; ss += h2[j] * h2[j]; }
            if (l == 0) *(u32x2*)((bf16_t*)p.out + off) = pk4(h2);
            else *(f32x4*)(p.out + O_Y + off) = h2;
            ss += __shfl_xor(ss, 1); ss += __shfl_xor(ss, 2); ss += __shfl_xor(ss, 4);
            if (sq == 0) ((float*)(ws + OFF_PART))[(size_t)row * 32 + t.pn * 8 + t.wc * 2 + t.bj] = ss;
        }
    }
}

struct WtDesc { const float* src; const float* gscale; bf16_t* dst; int ld_src, ld_dst, k0, c0; };
DI WtDesc wt_desc(CParams& p, int it) {
    WtDesc d; const int l = it / 2816; int r = it % 2816;
    unsigned char* wt = p.ws + OFF_WT + (size_t)l * WT_LAYER;
    d.gscale = nullptr;
    if (r < 1664) { const int kt = r / 104, ctile = r % 104;
        d.src = p.w_in + (size_t)l * 1024 * NCOL; d.ld_src = NCOL; d.k0 = kt * 64; d.c0 = ctile * 64; d.dst = (bf16_t*)(wt + WT_IN); d.ld_dst = 1024; d.gscale = p.norm_g + l * 1024;
    } else if ((r -= 1664) < 64) { const int g = r >> 4, kt = (r >> 2) & 3, ctile = r & 3;
        d.src = p.pool_map + (size_t)(l * 4 + g) * 65536; d.ld_src = 256; d.k0 = kt * 64; d.c0 = ctile * 64; d.dst = (bf16_t*)(wt + WT_PM) + (size_t)g * 65536; d.ld_dst = 256;
    } else if ((r -= 64) < 1024) { const int w = r >> 8, kt = (r >> 4) & 15, ctile = r & 15;
        d.src = (w == 0 ? p.w_proj_pool : w == 1 ? p.w_proj_attn : w == 2 ? p.w_out : p.w_ple_gate) + (size_t)l * 1048576;
        d.dst = (bf16_t*)(wt + (w == 0 ? WT_PP : w == 1 ? WT_PA : w == 2 ? WT_WO : WT_WG)); d.ld_src = 1024; d.ld_dst = 1024; d.k0 = kt * 64; d.c0 = ctile * 64;
    } else { r -= 1024; const int kt = r >> 4, ctile = r & 15;
        d.src = p.w_ple + (size_t)l * 262144; d.ld_src = 1024; d.k0 = kt * 64; d.c0 = ctile * 64; d.dst = (bf16_t*)(wt + WT_PLE); d.ld_dst = 256;
    }
    return d;
}
DI void wt_load(const WtDesc& d, int tid, f32x4& v0, f32x4& v1) {
    const int kk = tid >> 4, c4 = (tid & 15) * 4;
    v0 = __builtin_nontemporal_load((const f32x4*)(d.src + (size_t)(d.k0 + kk) * d.ld_src + d.c0 + c4));
    v1 = __builtin_nontemporal_load((const f32x4*)(d.src + (size_t)(d.k0 + kk + 32) * d.ld_src + d.c0 + c4));
    if (d.gscale) { v0 *= d.gscale[d.k0 + kk]; v1 *= d.gscale[d.k0 + kk + 32]; }
}

DI void phase0(CParams& p, LAS unsigned char* lds, int h, int bid, int G) {
    const int tid = tidx();
    LAS float* tile = (LAS float*)lds;
    {
        const int it_end = h == 0 ? 1664 : 2 * 2816;
        int it = (h == 0 ? 0 : 1664) + bid;
        WtDesc d = wt_desc(p, it < it_end ? it : 0);
        f32x4 v0, v1; wt_load(d, tid, v0, v1);
        for (; it < it_end; it += G) {
            const int nit = it + G < it_end ? it + G : it;
            const WtDesc dn = wt_desc(p, nit);
            f32x4 n0, n1; wt_load(dn, tid, n0, n1);
            __syncthreads();
            { const int kk = tid >> 4, c4 = (tid & 15) * 4;
#pragma unroll
              for (int j = 0; j < 4; ++j) { tile[(c4 + j) * 65 + kk] = v0[j]; tile[(c4 + j) * 65 + kk + 32] = v1[j]; } }
            __syncthreads();
            { const int cc = tid >> 3, ks = (tid & 7) * 8;
              int c = d.c0 + cc;
              if (d.gscale && c >= 4608) {
                  const int gcol = (c - 4608) & 1023, isb = (c - 4608) >> 10, lc = gcol & 127;
                  c = (18 + (gcol >> 7)) * 256 + 128 * isb + 32 * (lc >> 5) + 16 * ((lc >> 2) & 1) + 4 * ((lc >> 3) & 3) + (lc & 3);
              } else { const int a = c & 255; c = (c & ~255) + (128 * ((a >> 3) & 1) + 32 * (a >> 6) + 16 * ((a >> 2) & 1) + 4 * ((a >> 4) & 3) + (a & 3)); }
              u32x4 o;
              o[0] = pk2(tile[cc * 65 + ks + 0], tile[cc * 65 + ks + 1]); o[1] = pk2(tile[cc * 65 + ks + 2], tile[cc * 65 + ks + 3]);
              o[2] = pk2(tile[cc * 65 + ks + 4], tile[cc * 65 + ks + 5]); o[3] = pk2(tile[cc * 65 + ks + 6], tile[cc * 65 + ks + 7]);
              *(u32x4*)(d.dst + (size_t)c * d.ld_dst + d.k0 + ks) = o; }
            d = dn; v0 = n0; v1 = n1;
        }
    }
    {
        bf16_t* XB = (bf16_t*)(p.ws + OFF_SA); float* part = (float*)(p.ws + OFF_PART);
        const int wid = tid >> 6, lane = tid & 63;
        for (int rl0 = bid * 8 + wid; rl0 < 8448; rl0 += 2 * G * 8) {
            const int rlb = rl0 + G * 8; const bool hasb = rlb < 8448; const int rl1 = hasb ? rlb : rl0;
            const int row0 = rl0 < 8192 ? 8192 * h + rl0 : TP + 256 * h + (rl0 - 8192), row1 = rl1 < 8192 ? 8192 * h + rl1 : TP + 256 * h + (rl1 - 8192);
            const float* s0 = row0 < TP ? p.x_prompt + (size_t)row0 * 1024 : p.x_sample + (size_t)(row0 - TP) * 1024;
            const float* s1 = row1 < TP ? p.x_prompt + (size_t)row1 * 1024 : p.x_sample + (size_t)(row1 - TP) * 1024;
            f32x4 a[4], b[4];
#pragma unroll
            for (int j = 0; j < 4; ++j) { a[j] = __builtin_nontemporal_load((const f32x4*)(s0 + j * 256 + lane * 4)); b[j] = __builtin_nontemporal_load((const f32x4*)(s1 + j * 256 + lane * 4)); }
            float sa = 0.f, sb = 0.f;
#pragma unroll
            for (int j = 0; j < 4; ++j) {
                sa += a[j][0] * a[j][0] + a[j][1] * a[j][1] + a[j][2] * a[j][2] + a[j][3] * a[j][3];
                sb += b[j][0] * b[j][0] + b[j][1] * b[j][1] + b[j][2] * b[j][2] + b[j][3] * b[j][3];
                *(u32x2*)(XB + (size_t)row0 * 1024 + j * 256 + lane * 4) = pk4(a[j]);
                if (hasb) *(u32x2*)(XB + (size_t)row1 * 1024 + j * 256 + lane * 4) = pk4(b[j]);
            }
#pragma unroll
            for (int o = 32; o >= 1; o >>= 1) { sa += __shfl_xor(sa, o); sb += __shfl_xor(sb, o); }
            if (lane < 32) { part[(size_t)row0 * 32 + lane] = lane == 0 ? sa : 0.f; if (hasb) part[(size_t)row1 * 32 + lane] = lane == 0 ? sb : 0.f; }
        }
    }
    {
        float* rope = (float*)(p.ws + OFF_ROPE);
        for (int idx = bid * 512 + tid; h == 0 && idx < 8196 * 8; idx += G * 512) {
            const int pi = idx >> 3, i = idx & 7;
            const int pos = pi < SEQ ? pi : 16384 + (pi - SEQ);
            const float angf = (float)pos * p.inv_freq[i];
            const double tt = (double)angf * 0.15915494309189533577;
            const float fr = (float)(tt - __builtin_floor(tt));
            rope[(size_t)pi * 16 + i] = __builtin_amdgcn_cosf(fr);
            rope[(size_t)pi * 16 + 8 + i] = __builtin_amdgcn_sinf(fr);
        }
    }
}

DI int crow(int reg, int h) { return (reg & 3) + 8 * (reg >> 2) + 4 * h; }
#define MFMA32(a, b, c) __builtin_amdgcn_mfma_f32_32x32x16_bf16((a), (b), (c), 0, 0, 0)

DI void attn_prompt_item(CParams& p, int l, int item, LAS unsigned char* lds) {
    const int tid = tidx(), wid = tid >> 6, lane = tid & 63;
    const int kh = item & 3, nb = (item >> 2) & 63, b = item >> 8;
    bf16_t* Q = (bf16_t*)(p.ws + OFF_SC);
    const bf16_t* KB = (const bf16_t*)(p.ws + OFF_SE + 2 * PANEL);
    const bf16_t* VB = (const bf16_t*)(p.ws + OFF_SE + 3 * PANEL);
    const bf16_t* SZA = (const bf16_t*)(p.ws + OFF_SD);
    LAS unsigned char* Ks = lds; LAS unsigned char* Vt = lds + 36864;
    __syncthreads();
    const long tk0 = (long)b * SEQ + 128 * (nb - 1);
#pragma unroll
    for (int e = 0; e < 4; ++e) {
        const int idx = tid + 512 * e, key = idx >> 3, seg = idx & 7;
        u32x4 v = {0u, 0u, 0u, 0u};
        if (nb > 0 || key >= 128) v = *(const u32x4*)(KB + (size_t)(tk0 + key) * 256 + kh * 64 + seg * 8);
        *(LAS u32x4*)(Ks + key * 144 + seg * 16) = v;
    }
    {
        const int key = tid & 255, half = tid >> 8; const bool ok = nb > 0 || key >= 128;
#pragma unroll
        for (int e = 0; e < 4; ++e) {
            u32x4 v = {0u, 0u, 0u, 0u};
            if (ok) v = *(const u32x4*)(VB + (size_t)(tk0 + key) * 256 + kh * 64 + half * 32 + e * 8);
#pragma unroll
            for (int jj = 0; jj < 4; ++jj) {
                const int d = half * 32 + e * 8 + 2 * jj;
                *(LAS unsigned short*)(Vt + d * 528 + key * 2) = (unsigned short)(v[jj] & 0xffffu);
                *(LAS unsigned short*)(Vt + (d + 1) * 528 + key * 2) = (unsigned short)(v[jj] >> 16);
            }
        }
    }
    __syncthreads();
    const int g = wid >> 1, rh = wid & 1, h = kh * 4 + g, r = lane & 31, hh = lane >> 5;
    const float sink = p.sinks[l * 16 + h];
    const float NEG = -__builtin_inff();
#pragma unroll 1
    for (int sbk = 0; sbk < 2; ++sbk) {
        const int wq = 2 * rh + sbk;
        const size_t tq = (size_t)b * SEQ + 128 * nb + 32 * wq + r;
        bf16x8 qf[4];
#pragma unroll
        for (int s = 0; s < 4; ++s) qf[s] = *(const bf16x8*)(Q + tq * 1024 + h * 64 + 16 * s + 8 * hh);
        f32x16 st[5];
#pragma unroll
        for (int kt = 0; kt < 5; ++kt) {
            const int jb = 32 * (wq + kt);
            f32x16 a;
#pragma unroll
            for (int i = 0; i < 16; ++i) a[i] = 0.f;
#pragma unroll
            for (int s = 0; s < 4; ++s) {
                const bf16x8 kf = *(const LAS bf16x8*)(Ks + (jb + r) * 144 + (16 * s + 8 * hh) * 2);
                a = MFMA32(kf, qf[s], a);
            }
            st[kt] = a;
        }
#pragma unroll
        for (int i = 0; i < 16; ++i) {
            const int kr = crow(i, hh);
            if (kr < r) st[0][i] = NEG;
            if (kr > r) st[4][i] = NEG;
        }
        if (nb == 0) {
#pragma unroll
            for (int kt = 0; kt < 4; ++kt)
                if (wq + kt < 4) {
#pragma unroll
                    for (int i = 0; i < 16; ++i) st[kt][i] = NEG;
                }
        }
        float mx = sink;
#pragma unroll
        for (int kt = 0; kt < 5; ++kt)
#pragma unroll
            for (int i = 0; i < 16; ++i) mx = fmaxf(mx, st[kt][i]);
        mx = fmaxf(mx, __shfl_xor(mx, 32));
        float sum = 0.f;
#pragma unroll
        for (int kt = 0; kt < 5; ++kt)
#pragma unroll
            for (int i = 0; i < 16; ++i) { const float e = __expf(st[kt][i] - mx); st[kt][i] = e; sum += e; }
        sum += __shfl_xor(sum, 32);
        sum += __expf(sink - mx);
        const float inv = 1.f / sum;
        f32x16 o0, o1;
#pragma unroll
        for (int i = 0; i < 16; ++i) { o0[i] = 0.f; o1[i] = 0.f; }
#pragma unroll
        for (int kt = 0; kt < 5; ++kt) {
            const int jb = 32 * (wq + kt);
#pragma unroll
            for (int s2 = 0; s2 < 2; ++s2) {
                u32x4 pw;
                pw[0] = pk2(st[kt][8 * s2 + 0], st[kt][8 * s2 + 1]); pw[1] = pk2(st[kt][8 * s2 + 2], st[kt][8 * s2 + 3]);
                pw[2] = pk2(st[kt][8 * s2 + 4], st[kt][8 * s2 + 5]); pw[3] = pk2(st[kt][8 * s2 + 6], st[kt][8 * s2 + 7]);
                const bf16x8 xs = __builtin_bit_cast(bf16x8, pw);
                const int ko = (jb + 16 * s2 + 4 * hh) * 2;
                const s16x4 v0a = *(const LAS s16x4*)(Vt + r * 528 + ko), v0b = *(const LAS s16x4*)(Vt + r * 528 + ko + 16);
                const s16x4 v1a = *(const LAS s16x4*)(Vt + (r + 32) * 528 + ko), v1b = *(const LAS s16x4*)(Vt + (r + 32) * 528 + ko + 16);
                const bf16x8 vf0 = __builtin_shufflevector(v0a, v0b, 0, 1, 2, 3, 4, 5, 6, 7), vf1 = __builtin_shufflevector(v1a, v1b, 0, 1, 2, 3, 4, 5, 6, 7);
                o0 = MFMA32(vf0, xs, o0); o1 = MFMA32(vf1, xs, o1);
            }
        }
#pragma unroll
        for (int g4 = 0; g4 < 4; ++g4) {
            const int d0 = 8 * g4 + 4 * hh;
            {
                const size_t off = tq * 1024 + h * 64 + d0;
                const f32x4 z = unpk4(*(const u32x2*)(SZA + off));
                f32x4 v; v[0] = o0[4 * g4] * inv * z[0]; v[1] = o0[4 * g4 + 1] * inv * z[1]; v[2] = o0[4 * g4 + 2] * inv * z[2]; v[3] = o0[4 * g4 + 3] * inv * z[3];
                *(u32x2*)(Q + off) = pk4(v);
            }
            {
                const size_t off = tq * 1024 + h * 64 + 32 + d0;
                const f32x4 z = unpk4(*(const u32x2*)(SZA + off));
                f32x4 v; v[0] = o1[4 * g4] * inv * z[0]; v[1] = o1[4 * g4 + 1] * inv * z[1]; v[2] = o1[4 * g4 + 2] * inv * z[2]; v[3] = o1[4 * g4 + 3] * inv * z[3];
                *(u32x2*)(Q + off) = pk4(v);
            }
        }
    }
}

DI void attn_sample_item(CParams& p, int l, int item, LAS unsigned char* lds) {
    const int tid = tidx(), wid = tid >> 6, lane = tid & 63;
    const int sb = item >> 1, h = (item & 1) * 8 + wid, kh = h >> 2;
    bf16_t* Q = (bf16_t*)(p.ws + OFF_SC);
    const bf16_t* KB = (const bf16_t*)(p.ws + OFF_SE + 2 * PANEL);
    const bf16_t* VB = (const bf16_t*)(p.ws + OFF_SE + 3 * PANEL);
    const bf16_t* SZA = (const bf16_t*)(p.ws + OFF_SD);
    LAS float* wq_ = (LAS float*)(lds + wid * 4096);
    LAS float* sc = wq_ + 256;
    const size_t tq0 = (size_t)TP + 4 * sb;
    const float sink = p.sinks[l * 16 + h];
    __syncthreads();
#pragma unroll
    for (int i = 0; i < 4; ++i) wq_[i * 64 + lane] = bf1(Q[(tq0 + i) * 1024 + h * 64 + lane]);
    __syncthreads();
    const int kq = lane >> 4, ds = lane & 15;
    f32x4 qv[4];
#pragma unroll
    for (int i = 0; i < 4; ++i) qv[i] = *(const LAS f32x4*)(wq_ + i * 64 + ds * 4);
    const size_t cbase = ((size_t)(l * 128 + sb) * 128 * 4 + kh) * 64;
    const float* ck = p.cache_k + cbase + ds * 4; const float* cv = p.cache_v + cbase + ds * 4;
#pragma unroll 1
    for (int it0 = 0; it0 < 32; it0 += 8) {
        f32x4 kv[8];
#pragma unroll
        for (int u = 0; u < 8; ++u) kv[u] = *(const f32x4*)(ck + (size_t)(4 * (it0 + u) + kq) * 256);
#pragma unroll
        for (int u = 0; u < 8; ++u) {
            const int c = 4 * (it0 + u) + kq;
            float d[4];
#pragma unroll
            for (int i = 0; i < 4; ++i) {
                float x = kv[u][0] * qv[i][0] + kv[u][1] * qv[i][1] + kv[u][2] * qv[i][2] + kv[u][3] * qv[i][3];
                x += __shfl_xor(x, 1); x += __shfl_xor(x, 2); x += __shfl_xor(x, 4); x += __shfl_xor(x, 8);
                d[i] = x;
            }
            const float my = ds == 0 ? d[0] : ds == 1 ? d[1] : ds == 2 ? d[2] : d[3];
            if (ds < 4) sc[c * 4 + ds] = my;
        }
    }
    {
        const f32x4 kv = unpk4(*(const u32x2*)(KB + (tq0 + kq) * 256 + kh * 64 + ds * 4));
        float d[4];
#pragma unroll
        for (int i = 0; i < 4; ++i) {
            float x = kv[0] * qv[i][0] + kv[1] * qv[i][1] + kv[2] * qv[i][2] + kv[3] * qv[i][3];
            x += __shfl_xor(x, 1); x += __shfl_xor(x, 2); x += __shfl_xor(x, 4); x += __shfl_xor(x, 8);
            d[i] = x;
        }
        const float my = ds == 0 ? d[0] : ds == 1 ? d[1] : ds == 2 ? d[2] : d[3];
        if (ds < 4) sc[(128 + kq) * 4 + ds] = my;
    }
    __syncthreads();
#pragma unroll
    for (int i = 0; i < 4; ++i) {
        const float NEG = -__builtin_inff();
        float s0 = sc[lane * 4 + i], s1 = sc[(lane + 64) * 4 + i], s2 = lane < 4 ? sc[(128 + lane) * 4 + i] : NEG;
        if (lane < i) s0 = NEG;
        if (lane > i) s2 = NEG;
        float mx = fmaxf(fmaxf(s0, s1), fmaxf(s2, sink));
#pragma unroll
        for (int o = 32; o >= 1; o >>= 1) mx = fmaxf(mx, __shfl_xor(mx, o));
        const float e0 = __expf(s0 - mx), e1 = __expf(s1 - mx), e2 = __expf(s2 - mx);
        float sum = e0 + e1 + e2;
#pragma unroll
        for (int o = 32; o >= 1; o >>= 1) sum += __shfl_xor(sum, o);
        sum += __expf(sink - mx);
        const float inv = 1.f / sum;
        sc[lane * 4 + i] = e0 * inv; sc[(lane + 64) * 4 + i] = e1 * inv; if (lane < 4) sc[(128 + lane) * 4 + i] = e2 * inv;
    }
    __syncthreads();
    f32x4 o[4];
#pragma unroll
    for (int i = 0; i < 4; ++i) o[i] = (f32x4){0.f, 0.f, 0.f, 0.f};
#pragma unroll 1
    for (int it0 = 0; it0 < 32; it0 += 8) {
        f32x4 vv[8];
#pragma unroll
        for (int u = 0; u < 8; ++u) vv[u] = *(const f32x4*)(cv + (size_t)(4 * (it0 + u) + kq) * 256);
#pragma unroll
        for (int u = 0; u < 8; ++u) {
            const f32x4 pr = *(const LAS f32x4*)(sc + (4 * (it0 + u) + kq) * 4);
#pragma unroll
            for (int i = 0; i < 4; ++i) o[i] += vv[u] * pr[i];
        }
    }
    {
        const f32x4 vv = unpk4(*(const u32x2*)(VB + (tq0 + kq) * 256 + kh * 64 + ds * 4));
        const f32x4 pr = *(const LAS f32x4*)(sc + (128 + kq) * 4);
#pragma unroll
        for (int i = 0; i < 4; ++i) o[i] += vv * pr[i];
    }
#pragma unroll
    for (int i = 0; i < 4; ++i)
#pragma unroll
        for (int j = 0; j < 4; ++j) { float x = o[i][j]; x += __shfl_xor(x, 16); x += __shfl_xor(x, 32); o[i][j] = x; }
    {
        const f32x4 mine = kq == 0 ? o[0] : kq == 1 ? o[1] : kq == 2 ? o[2] : o[3];
        const size_t off = (tq0 + kq) * 1024 + h * 64 + ds * 4;
        const f32x4 z = unpk4(*(const u32x2*)(SZA + off));
        *(u32x2*)(Q + off) = pk4(mine * z);
    }
}

template <int W>
DI void pool_prompt_body(const bf16_t* U, bf16_t* R, int t0) {
    f32x2 prev[16], cur[16];
#pragma unroll
    for (int j = 0; j < 16; ++j) {
        prev[j] = (f32x2){0.f, 0.f};
        if (j >= 17 - W) { const int t = t0 - 16 + j; if (t >= 0) { const unsigned u = *(const unsigned*)(U + (size_t)t * 1024); prev[j] = (f32x2){bflo(u), bfhi(u)}; } }
    }
#pragma unroll 1
    for (int ch = 0; ch < 4; ++ch) {
        const int tb = t0 + ch * 16;
#pragma unroll
        for (int j = 0; j < 16; ++j) { const unsigned u = *(const unsigned*)(U + (size_t)(tb + j) * 1024); cur[j] = (f32x2){bflo(u), bfhi(u)}; }
#pragma unroll
        for (int i = 0; i < 16; ++i) {
            f32x2 sum = cur[i];
#pragma unroll
            for (int j = 1; j < W; ++j) sum += (i - j >= 0) ? cur[i - j >= 0 ? i - j : 0] : prev[i - j >= 0 ? 0 : 16 + i - j];
            const int t = tb + i;
            const float ic = 1.f / (float)(t + 1 < W ? t + 1 : W);
            const f32x2 r = sum * ic - cur[i];
            *(unsigned*)(R + (size_t)t * 1024) = pk2(r[0], r[1]);
        }
#pragma unroll
        for (int j = 0; j < 16; ++j) prev[j] = cur[j];
    }
}

DI void pool_prompt_item(CParams& p, int item) {
    const int tid = tidx(), g = __builtin_amdgcn_readfirstlane(tid >> 7);
    const int b = item >> 7, t0 = (item & 127) * 64;
    const bf16_t* U = (const bf16_t*)(p.ws + OFF_SB) + (size_t)b * SEQ * 1024 + 2 * tid;
    bf16_t* R = (bf16_t*)(p.ws + OFF_SF) + (size_t)b * SEQ * 1024 + 2 * tid;
    if (g == 0) pool_prompt_body<2>(U, R, t0);
    else if (g == 1) pool_prompt_body<4>(U, R, t0);
    else if (g == 2) pool_prompt_body<8>(U, R, t0);
    else pool_prompt_body<16>(U, R, t0);
}

DI void pool_sample_item(CParams& p, int l, int item) {
    const int tid = tidx(), g = tid >> 7;
    const float iw = g == 0 ? 0.5f : g == 1 ? 0.25f : g == 2 ? 0.125f : 0.0625f;
    {
        const int sb = item;
        const float* st = p.state_pool + (size_t)(l * 128 + sb) * 15 * 1024 + 2 * tid;
        float* np = p.out + O_PS + (size_t)(l * 128 + sb) * 15 * 1024 + 2 * tid;
        const bf16_t* U = (const bf16_t*)(p.ws + OFF_SB) + ((size_t)TP + 4 * sb) * 1024 + 2 * tid;
        bf16_t* R = (bf16_t*)(p.ws + OFF_SF) + ((size_t)TP + 4 * sb) * 1024 + 2 * tid;
        f32x2 pv[19], cs[20];
#pragma unroll
        for (int j = 0; j < 15; ++j) pv[j] = *(const f32x2*)(st + (size_t)j * 1024);
#pragma unroll
        for (int j = 0; j < 4; ++j) { const unsigned u = *(const unsigned*)(U + (size_t)j * 1024); pv[15 + j] = (f32x2){bflo(u), bfhi(u)}; }
#pragma unroll
        for (int j = 4; j < 15; ++j) *(f32x2*)(np + (size_t)(j - 4) * 1024) = pv[j];
        cs[0] = (f32x2){0.f, 0.f};
#pragma unroll
        for (int j = 0; j < 19; ++j) cs[j + 1] = cs[j] + pv[j];
#pragma unroll
        for (int i = 0; i < 4; ++i) {
            const f32x2 start = g == 0 ? cs[14 + i] : g == 1 ? cs[12 + i] : g == 2 ? cs[8 + i] : cs[i];
            const f32x2 r = (cs[16 + i] - start) * iw - pv[15 + i];
            *(unsigned*)(R + (size_t)i * 1024) = pk2(r[0], r[1]);
        }
    }
}

DI void cache_copy_item(CParams& p, int l, int item) {
    const int tid = tidx(), sb = item >> 1;
    const size_t base = (size_t)(l * 128 + sb) * 128 * 256;
    const f32x4* src = (const f32x4*)(((item & 1) ? p.cache_v : p.cache_k) + base + 4 * 256) + tid;
    f32x4* dst = (f32x4*)(p.out + ((item & 1) ? O_VS : O_KS) + base) + tid;
#pragma unroll 1
    for (int i0 = 0; i0 < 15; i0 += 5) {
        f32x4 v[5];
#pragma unroll
        for (int u = 0; u < 5; ++u) v[u] = __builtin_nontemporal_load(src + (size_t)(i0 + u) * 512);
#pragma unroll
        for (int u = 0; u < 5; ++u) __builtin_nontemporal_store(v[u], dst + (size_t)(i0 + u) * 512);
    }
    if (tid < 256) { const f32x4 v = __builtin_nontemporal_load(src + (size_t)15 * 512); __builtin_nontemporal_store(v, dst + (size_t)15 * 512); }
}

DI void phase2(CParams& p, int l, LAS unsigned char* lds, int h, int c, int G) {
    for (int it = c; it < 704; it += G) {
        if (it < 128) attn_sample_item(p, l, 128 * h + it, lds);
        else if (it < 384) attn_prompt_item(p, l, (h << 8) | (it - 128), lds);
        else if (it < 512) cache_copy_item(p, l, 128 * h + (it - 384));
        else if (it < 640) pool_prompt_item(p, 128 * h + (it - 512));
        else pool_sample_item(p, l, 64 * h + (it - 640));
    }
}

DI void convert_p(CParams& p, int l, int h, int c, int G) {
    bf16_t* PB = (bf16_t*)(p.ws + OFF_SE);
    const size_t n8 = (size_t)(8192 + 256) * 256 / 8;
    const size_t i0 = (size_t)c * 512 + tidx(), stride = (size_t)G * 512;
#pragma unroll 1
    for (size_t ib = i0; ib < n8; ib += 5 * stride) {
        f32x4 a[5], b[5]; size_t eo[5];
#pragma unroll
        for (int q = 0; q < 5; ++q) {
            const size_t i = ib + q * stride; const bool ok = i < n8; const size_t el = (ok ? i : i0) * 8;
            const size_t e = el < (size_t)8192 * 256 ? (size_t)h * 8192 * 256 + el : (size_t)TP * 256 + (size_t)h * 256 * 256 + (el - (size_t)8192 * 256);
            const float* src = e < (size_t)TP * 256 ? p.p_prompt + (size_t)l * TP * 256 + e : p.p_sample + (size_t)l * TS * 256 + (e - (size_t)TP * 256);
            a[q] = __builtin_nontemporal_load((const f32x4*)src); b[q] = __builtin_nontemporal_load((const f32x4*)(src + 4));
            eo[q] = ok ? e : (size_t)-1;
        }
#pragma unroll
        for (int q = 0; q < 5; ++q) if (eo[q] != (size_t)-1) {
            u32x4 o; o[0] = pk2(a[q][0], a[q][1]); o[1] = pk2(a[q][2], a[q][3]); o[2] = pk2(b[q][0], b[q][1]); o[3] = pk2(b[q][2], b[q][3]);
            *(u32x4*)(PB + eo[q]) = o;
        }
    }
}

#define XB_TMO      128
#define XB_XCNT(j)  (256  + 64 * (j))
#define XB_XSUB(j)  (1280 + 64 * (j))
#define XB_XGEN(j)  (2304 + 64 * (j))
#define XB_TOP      3328
#define XB_TOPGEN   3392
#define XCD_BAR_WORDS 3456
#define XB_SPIN_CAP (1u << 20)
DI unsigned xb_ld(unsigned* p) { return __hip_atomic_load(p, __ATOMIC_RELAXED, __HIP_MEMORY_SCOPE_AGENT); }
DI unsigned xb_add(unsigned* p, unsigned v) { return __hip_atomic_fetch_add(p, v, __ATOMIC_RELAXED, __HIP_MEMORY_SCOPE_AGENT); }
DI unsigned xb_xcc_id() { return (unsigned)__builtin_amdgcn_s_getreg((3 << 11) | 20) & 0xFu; }
#define XB_SPIN(cond, bar) do { unsigned _sp = 0; while (cond) { __builtin_amdgcn_s_sleep(1); \
    if ((++_sp & 255u) == 0u) { if (xb_ld(&(bar)[XB_TMO])) break; if (_sp > XB_SPIN_CAP) { atomicAdd(&(bar)[XB_TMO], 1u); break; } } } } while (0)
struct XcdBarrier { unsigned* bar; unsigned x; volatile LAS unsigned* st; unsigned total; };
DI XcdBarrier xcd_barrier_post(unsigned* bar, volatile LAS unsigned* st, unsigned total) {
    XcdBarrier b; b.bar = bar; b.x = xb_xcc_id(); b.st = st; b.total = total;
    if (threadIdx.x == 0) (void)xb_add(&bar[XB_XCNT(b.x)], 1u);
    return b;
}
DI void xcd_barrier_complete(unsigned* bar, unsigned x, unsigned G, unsigned& nloc, unsigned& nx) {
    unsigned sum, cnt, mine, sp = 0u;
    for (;;) {
        sum = 0u; cnt = 0u; mine = 0u;
#pragma unroll
        for (unsigned j = 0; j < 16; ++j) { const unsigned c = xb_ld(&bar[XB_XCNT(j)]); sum += c; cnt += (c > 0u) ? 1u : 0u; mine = (j == x) ? c : mine; }
        if (sum == G) break;
        __builtin_amdgcn_s_sleep(1);
        if ((++sp & 255u) == 0u) { if (xb_ld(&bar[XB_TMO])) break; if (sp > XB_SPIN_CAP) { atomicAdd(&bar[XB_TMO], 1u); break; } }
    }
    nloc = mine > 0u ? mine : 1u; nx = cnt > 0u ? cnt : 1u;
}
DI void xcd_barrier(const XcdBarrier& b) {
    asm volatile("s_waitcnt vmcnt(0)" ::: "memory");
    __syncthreads();
    if (threadIdx.x == 0) {
        unsigned* bar = b.bar;
        __builtin_amdgcn_s_waitcnt(0);
        unsigned nloc = b.st[0], nx = b.st[1];
        if (nloc == 0u) { xcd_barrier_complete(bar, b.x, b.total, nloc, nx); b.st[0] = nloc; b.st[1] = nx; }
        const unsigned old = xb_add(&bar[XB_XSUB(b.x)], 1u);
        const unsigned gen = old / nloc;
        if (old + 1u == (gen + 1u) * nloc) {
            __builtin_amdgcn_fence(__ATOMIC_RELEASE, "agent");
            asm volatile("s_waitcnt vmcnt(0)" ::: "memory");
            const unsigned og = xb_add(&bar[XB_TOP], 1u);
            const unsigned tg = og / nx;
            if (og + 1u == (tg + 1u) * nx) xb_add(&bar[XB_TOPGEN], 1u);
            else XB_SPIN(xb_ld(&bar[XB_TOPGEN]) == tg, bar);
            __builtin_amdgcn_fence(__ATOMIC_ACQUIRE, "agent");
            xb_add(&bar[XB_XGEN(b.x)], 1u);
            asm volatile("s_waitcnt vmcnt(0)" ::: "memory");
        } else {
            XB_SPIN(xb_ld(&bar[XB_XGEN(b.x)]) == gen, bar);
            __builtin_amdgcn_fence(__ATOMIC_ACQUIRE, "agent");
            asm volatile("s_waitcnt vmcnt(0)" ::: "memory");
        }
    }
    __syncthreads();
}

DI void flag_wait(unsigned* flag) {
    if (threadIdx.x == 0) {
        unsigned sp = 0;
        while (xb_ld(flag) == 0u) { __builtin_amdgcn_s_sleep(2); if (++sp > (1u << 22)) break; }
        __builtin_amdgcn_fence(__ATOMIC_ACQUIRE, "agent");
        asm volatile("s_waitcnt vmcnt(0)" ::: "memory");
    }
    __syncthreads();
}
__global__ void __launch_bounds__(512, 2) mega(Params p_, int ph_lo, int ph_hi) {
    extern __shared__ __attribute__((aligned(16))) unsigned char shm[];
    LAS unsigned char* lds = (LAS unsigned char*)shm;
    const int G = gridDim.x, GH = G >> 1;
    volatile LAS unsigned* bst = (volatile LAS unsigned*)(lds + STAGE_BYTES);
    unsigned* barw = (unsigned*)(p_.ws + OFF_BAR);
    constexpr int BSTRIDE = XCD_BAR_WORDS + 64;
    const bool single = ph_hi - ph_lo > 1;
    const int c = blockIdx.x;
    if (single) {
        if (threadIdx.x < 8) bst[threadIdx.x] = 0u;
        __syncthreads();
    }
    const int h = c & 1, ch = c >> 1;
    unsigned* flags = barw + 3 * BSTRIDE - 32;
    XcdBarrier xbar;
    if (single) xbar = xcd_barrier_post(barw + (1 + h) * BSTRIDE, bst + 4, (unsigned)GH);
    if (ph_hi < 0) cg::this_grid().sync();
    for (int ph = ph_lo; ph < ph_hi; ++ph) {
        CParams* pq = (CParams*)__builtin_amdgcn_kernarg_segment_ptr(); asm volatile("" : "+s"(pq)); CParams& p = *pq;
        if (ph == 0) { if (ONLY < 0 || ONLY == 0) phase0(p, lds, h, ch, GH); }
        else {
            const int l = (ph - 1) / 7, s = (ph - 1) % 7;
            if (single && l == 0 && ((s == 0 && h == 1) || (s == 3 && h == 0))) flag_wait(flags + (1 - h));
            if ((s == 0 || s == 2) && (ONLY < 0 || ONLY == 1)) {
                SchedZ S; S.o.init(33, s == 0 ? 15 : 11); S.G = GH; S.c = ch; S.mode = s == 0 ? 0 : 1; S.l = l; S.h = h; S.p = pq;
                EpiZ E; E.l = l; E.p = pq; E.rs = (const LAS float*)(lds + STAGE_BYTES + 32);
                rstd_table(S, (const float*)(p.ws + OFF_PART), (LAS float*)(lds + STAGE_BYTES + 32));
                gemm_phase(lds, S, E);
            } else if (s == 1 && (ONLY < 0 || ONLY == 2)) {
                phase2(p, l, lds, h, ch, GH);
            } else if (s == 3 && (ONLY < 0 || ONLY == 3)) {
                SchedPool S; S.o.init(32, 4); S.G = GH; S.c = ch; S.l = l; S.h = h; S.p = pq;
                EpiPool E; E.l = l; E.p = pq;
                gemm_phase(lds, S, E);
                mini_phase(p, l, 3, ch, GH, h, lds);
            } else if (s == 4 && (ONLY < 0 || ONLY == 4)) {
                SchedMerge S; S.o.init(32, 4); S.G = GH; S.c = ch; S.l = l; S.h = h; S.p = pq;
                EpiMerge E; E.p = pq;
                convert_p(p, l, h, ch, GH);
                gemm_phase(lds, S, E);
                mini_phase(p, l, 4, ch, GH, h, lds);
            } else if (s == 5 && (ONLY < 0 || ONLY == 5)) {
                SchedRes1 S; S.o.init(32, 4); S.G = GH; S.c = ch; S.l = l; S.h = h; S.p = pq;
                EpiRes1 E; E.l = l; E.p = pq;
                gemm_phase(lds, S, E);
                mini_phase(p, l, 5, ch, GH, h, lds);
            } else if (s == 6 && (ONLY < 0 || ONLY == 6)) {
                SchedPlain S; S.o.init(32, 4); S.G = GH; S.c = ch; S.l = l; S.h = h; S.p = pq;
                EpiRes2 E; E.l = l; E.p = pq;
                gemm_phase(lds, S, E);
                mini_phase(p, l, 6, ch, GH, h, lds);
            }
        }
        if (ph + 1 < ph_hi) {
            xcd_barrier(xbar);
            if (ph == 0 && ch == 0 && threadIdx.x == 0) {
                __builtin_amdgcn_fence(__ATOMIC_RELEASE, "agent");
                asm volatile("s_waitcnt vmcnt(0)" ::: "memory");
                __hip_atomic_store(flags + h, 1u, __ATOMIC_RELAXED, __HIP_MEMORY_SCOPE_AGENT);
            }
        }
    }
}

extern "C" void kernel_launch(void* const* d_in, const int* in_sizes, int n_in, void* d_out, int out_size, void* d_ws, size_t ws_size, hipStream_t stream) {
    (void)in_sizes; (void)n_in; (void)out_size;
    if (ws_size < WS_NEED) { fprintf(stderr, "workspace too small: %zu < %zu\n", ws_size, (size_t)WS_NEED); return; }
    Params p{};
    p.x_prompt = (const float*)d_in[0]; p.x_sample = (const float*)d_in[1]; p.cache_k = (const float*)d_in[2]; p.cache_v = (const float*)d_in[3];
    p.state_pool = (const float*)d_in[4]; p.p_prompt = (const float*)d_in[5]; p.p_sample = (const float*)d_in[6]; p.norm_g = (const float*)d_in[7];
    p.w_in = (const float*)d_in[8]; p.q_norm_g = (const float*)d_in[9]; p.k_norm_g = (const float*)d_in[10]; p.sinks = (const float*)d_in[11];
    p.pool_map = (const float*)d_in[12]; p.pool_scale = (const float*)d_in[13]; p.w_proj_pool = (const float*)d_in[14]; p.w_proj_attn = (const float*)d_in[15];
    p.w_out = (const float*)d_in[16]; p.w_ple = (const float*)d_in[17]; p.w_ple_gate = (const float*)d_in[18];
    p.out = (float*)d_out; p.ws = (unsigned char*)d_ws;
    for (int i = 0; i < 8; ++i) p.inv_freq[i] = (float)pow(500000.0, -(double)i / 8.0);
    constexpr int LDS_BYTES = STAGE_BYTES + 32 + 8192;
    static bool attr_set = false;
    if (!attr_set) { hipFuncSetAttribute((const void*)mega, hipFuncAttributeMaxDynamicSharedMemorySize, LDS_BYTES); attr_set = true; }
    constexpr int NPH = 15;
#if COOP
    static int grid_blocks = 0;
    if (!grid_blocks) {
        int dev = 0, cus = 0, per_cu = 0;
        hipGetDevice(&dev);
        hipDeviceGetAttribute(&cus, hipDeviceAttributeMultiprocessorCount, dev);
        hipOccupancyMaxActiveBlocksPerMultiprocessor(&per_cu, mega, 512, LDS_BYTES);
        if (per_cu > 1) per_cu = 1;
        grid_blocks = cus * per_cu;
    }
    int lo = 0, hi = NPH;
    (void)hipMemsetAsync((unsigned char*)d_ws + OFF_BAR, 0, 3 * (XCD_BAR_WORDS + 64) * 4, stream);
    void* args[] = {&p, &lo, &hi};
    hipError_t e = hipLaunchCooperativeKernel((const void*)mega, dim3(grid_blocks), dim3(512), args, LDS_BYTES, stream);
    if (e != hipSuccess) fprintf(stderr, "cooperative launch failed: %s (grid %d)\n", hipGetErrorString(e), grid_blocks);
#else
    for (int ph = 0; ph < NPH; ++ph) hipLaunchKernelGGL(mega, dim3(256), dim3(512), LDS_BYTES, stream, p, ph, ph + 1);
#endif
}
```

```cpp
#include <hip/hip_runtime.h>
#include <hip/hip_cooperative_groups.h>
#include <cstdio>
#include <cmath>
namespace cg = cooperative_groups;

#ifndef COOP
#define COOP 1
#endif
#ifndef ONLY
#define ONLY -1
#endif

#define LAS __attribute__((address_space(3)))
#define DI __device__ __forceinline__
typedef unsigned short bf16_t;
typedef short bf16x8 __attribute__((ext_vector_type(8)));
typedef short s16x4 __attribute__((ext_vector_type(4)));
typedef float f32x2 __attribute__((ext_vector_type(2)));
typedef float f32x4 __attribute__((ext_vector_type(4)));
typedef float f32x16 __attribute__((ext_vector_type(16)));
typedef unsigned u32x2 __attribute__((ext_vector_type(2)));
typedef unsigned u32x4 __attribute__((ext_vector_type(4)));
typedef __bf16 bf2_t __attribute__((ext_vector_type(2)));

constexpr int TP = 16384, TS = 512, TT = 16896, DM = 1024, NCOL = 6656, SEQ = 8192;
constexpr int NPM = 66;
constexpr float EPS = 1e-6f;
constexpr size_t U1 = (size_t)TT * 1024 * 2;
constexpr size_t WT_IN = 0, WT_PM = WT_IN + (size_t)NCOL * 1024 * 2, WT_PP = WT_PM + 4 * 65536 * 2, WT_PA = WT_PP + 1048576 * 2,
                 WT_WO = WT_PA + 1048576 * 2, WT_PLE = WT_WO + 1048576 * 2, WT_WG = WT_PLE + 262144 * 2, WT_LAYER = WT_WG + 1048576 * 2;
constexpr size_t OFF_WT = 0, OFF_SA = OFF_WT + 2 * WT_LAYER, OFF_SB = OFF_SA + U1, OFF_SC = OFF_SB + U1, OFF_SD = OFF_SC + U1,
                 OFF_SE = OFF_SD + U1, OFF_SF = OFF_SE + U1, OFF_PART = OFF_SF + U1, OFF_ROPE = OFF_PART + (size_t)TT * 32 * 4,
                 OFF_YAS = OFF_ROPE + (size_t)8196 * 16 * 4, OFF_BAR = OFF_YAS + (size_t)TS * 1024 * 2, WS_NEED = OFF_BAR + 3 * (3456 + 64) * 4;
constexpr size_t PANEL = (size_t)TT * 256 * 2;
constexpr size_t O_Y = 0, O_KP = 17301504, O_VP = O_KP + 131072, O_PP = O_VP + 131072, O_KS = O_PP + 61440, O_VS = O_KS + 8388608,
                 O_PS = O_VS + 8388608;

struct Params {
    const float *x_prompt, *x_sample, *cache_k, *cache_v, *state_pool, *p_prompt, *p_sample, *norm_g, *w_in, *q_norm_g, *k_norm_g, *sinks,
        *pool_map, *pool_scale, *w_proj_pool, *w_proj_attn, *w_out, *w_ple, *w_ple_gate;
    float* out;
    unsigned char* ws;
    float inv_freq[8];
};

typedef const __attribute__((address_space(4))) Params CParams;
DI unsigned pk2(float a, float b) { f32x2 v = {a, b}; bf2_t r = __builtin_convertvector(v, bf2_t); return __builtin_bit_cast(unsigned, r); }
DI float bflo(unsigned u) { return __uint_as_float(u << 16); }
DI float bfhi(unsigned u) { return __uint_as_float(u & 0xffff0000u); }
DI float bf1(bf16_t u) { return __uint_as_float(((unsigned)u) << 16); }
DI float sigmoidf_(float v) { return __builtin_amdgcn_rcpf(1.f + __expf(-v)); }
DI float siluf_(float v) { return v * sigmoidf_(v); }
DI u32x2 pk4(f32x4 v) { u32x2 r; r.x = pk2(v[0], v[1]); r.y = pk2(v[2], v[3]); return r; }
DI f32x4 unpk4(u32x2 u) { f32x4 r; r[0] = bflo(u.x); r[1] = bfhi(u.x); r[2] = bflo(u.y); r[3] = bfhi(u.y); return r; }

DI int bidx() { int b = blockIdx.x; asm volatile("" : "+s"(b)); return b; }
DI int tidx() { int t = threadIdx.x; asm volatile("" : "+v"(t)); return t; }
template <class P> DI P* launder(P* q) { asm volatile("" : "+s"(q)); return q; }
constexpr int BM = 256, BK = 64, HALF = 128, HTB = HALF * BK * 2, STAGE_BYTES = 8 * HTB, NXCD = 8, WGM = 8;
DI int lds_byte(int r, int c) { const int st = (r >> 4) * 2 + (c >> 5), rr = r & 15, cc = c & 31, ob = rr * 64 + cc * 2; return st * 1024 + (ob ^ (((ob >> 9) & 1) << 5)); }
DI void stage_rc(int b, int& R, int& C) { const int st = b / 1024, sb = b % 1024, swz = sb ^ (((sb >> 9) & 1) << 5); R = (st >> 1) * 16 + swz / 64; C = (st & 1) * 32 + (swz % 64) / 2; }

struct Unit { const char* A; const char* B; unsigned lda, ldb; int nt, pm, pn, kind, idx; };
struct TileOrder {
    int nM, nN, nwg, nx;
    DI void init(int nM_, int nN_, int nx_ = 4) { nM = nM_; nN = nN_; nwg = nM_ * nN_; nx = nx_; }
    DI void map(int L, int& pm, int& pn) const {
        int wgid = L; { const int q = nwg / nx, r = nwg % nx, xcd = wgid % nx, off = wgid / nx; wgid = (xcd < r ? xcd * (q + 1) : r * (q + 1) + (xcd - r) * q) + off; }
        const int nig = WGM * nN, gid = wgid / nig, fm = gid * WGM, gsz = (nM - fm) < WGM ? (nM - fm) : WGM;
        pm = fm + ((wgid % nig) % gsz); pn = (wgid % nig) / gsz;
    }
};

typedef f32x4 Acc[2][2][4][2];

template <class Epi, class Sched>
DI void gemm_phase(LAS unsigned char* lds, const Sched& S, const Epi& E) {
    const int tid = tidx(), wid = __builtin_amdgcn_readfirstlane(tid >> 6), lane = tid & 63, wr = wid >> 2, wc = wid & 3, fr = lane & 15, fq = lane >> 4;
    int R0, C0, R1, C1; stage_rc(tid * 16, R0, C0); stage_rc(tid * 16 + 8192, R1, C1);
    const size_t kstep = (size_t)(BK * 2);
    const unsigned ldsw = (unsigned)wid * 1024u;
    const int aoff = lds_byte(wr * 64 + fr, fq * 8), boff = lds_byte(wc * 32 + fr, fq * 8);
#define G_SA(b, h) (((b) * 2 + (h)) * HTB)
#define G_SB(b, h) ((4 + (b) * 2 + (h)) * HTB)
#define G_STAGE(bufoff, gbase, v0, v1) do { \
        __builtin_amdgcn_global_load_lds((const unsigned*)((const char*)(gbase) + (v0)), (LAS unsigned*)(lds + (bufoff) + ldsw), 16, 0, 0); \
        __builtin_amdgcn_global_load_lds((const unsigned*)((const char*)(gbase) + (v1)), (LAS unsigned*)(lds + (bufoff) + ldsw + 8192), 16, 0, 0); } while (0)
#define G_LDA(dst, b, h) do { _Pragma("unroll") for (int m = 0; m < 4; ++m) _Pragma("unroll") for (int k = 0; k < 2; ++k) dst[m][k] = *(const LAS bf16x8*)(lds + G_SA(b, h) + aoff + m * 2048 + k * 1024); } while (0)
#define G_LDB(dst, b, h) do { _Pragma("unroll") for (int n = 0; n < 2; ++n) _Pragma("unroll") for (int k = 0; k < 2; ++k) dst[n][k] = *(const LAS bf16x8*)(lds + G_SB(b, h) + boff + n * 2048 + k * 1024); } while (0)
#define G_MMA(ai, bj, At, Bt) do { __builtin_amdgcn_s_setprio(1); _Pragma("unroll") for (int m = 0; m < 4; ++m) _Pragma("unroll") for (int n = 0; n < 2; ++n) _Pragma("unroll") for (int k = 0; k < 2; ++k) \
        acc[ai][bj][m][n] = __builtin_amdgcn_mfma_f32_16x16x32_bf16(Bt[n][k], At[m][k], acc[ai][bj][m][n], 0, 0, 0); __builtin_amdgcn_s_setprio(0); } while (0)
#define G_WAIT_V(n) asm volatile("s_waitcnt vmcnt(" #n ")" ::: "memory")
#define G_WAIT_L(n) asm volatile("s_waitcnt lgkmcnt(" #n ")" ::: "memory")
#define G_BAR __builtin_amdgcn_s_barrier()
#define G_SCHED __builtin_amdgcn_sched_barrier(0)
    Unit cur, nxt; int ui = 0;
    if (!S.next(0, cur)) return;
    Acc acc;
#pragma unroll
    for (int a = 0; a < 2; ++a)
#pragma unroll
        for (int b = 0; b < 2; ++b)
#pragma unroll
            for (int m = 0; m < 4; ++m)
#pragma unroll
                for (int n = 0; n < 2; ++n) acc[a][b][m][n] = (f32x4){0.f, 0.f, 0.f, 0.f};
    bf16x8 At[4][2], B0[2][2], B1[2][2];
    const char* cA = cur.A; const char* cB = cur.B;
    unsigned lda = cur.lda, ldb = cur.ldb;
    const unsigned C0b = C0 * 2, C1b = C1 * 2;
#define G_VO(R, Cb, ld) ((unsigned)(R) * (ld) + (Cb))
    unsigned vA0 = G_VO(R0, C0b, lda), vA1 = G_VO(R1, C1b, lda), vB0 = G_VO(R0, C0b, ldb), vB1 = G_VO(R1, C1b, ldb);
#define G_STA(bufoff, gbase, ld) do { if constexpr (Sched::VAR) G_STAGE(bufoff, gbase, G_VO(R0, C0b, ld), G_VO(R1, C1b, ld)); else G_STAGE(bufoff, gbase, vA0, vA1); } while (0)
#define G_STB(bufoff, gbase, ld) do { if constexpr (Sched::VAR) G_STAGE(bufoff, gbase, G_VO(R0, C0b, ld), G_VO(R1, C1b, ld)); else G_STAGE(bufoff, gbase, vB0, vB1); } while (0)
    size_t hA = (size_t)HALF * lda, hB = (size_t)HALF * ldb;
    G_STB(G_SB(0, 0), cB, ldb); G_STB(G_SB(0, 1), cB + hB, ldb); G_STA(G_SA(0, 0), cA, lda); G_STA(G_SA(0, 1), cA + hA, lda);
    if (wr == 1) G_BAR;
    G_WAIT_V(2); G_BAR;
    G_STB(G_SB(1, 0), cB + kstep, ldb); G_STA(G_SA(1, 0), cA + kstep, lda); G_STB(G_SB(1, 1), cB + hB + kstep, ldb);
    G_WAIT_V(6); G_BAR;
    for (;;) {
        const bool has_next = S.next(ui + 1, nxt);
        const char* nA = has_next ? nxt.A : cA; const char* nB = has_next ? nxt.B : cB;
        unsigned nlda = lda, nldb = ldb; size_t nhA = hA, nhB = hB;
        if constexpr (Sched::VAR) { nlda = has_next ? nxt.lda : lda; nldb = has_next ? nxt.ldb : ldb; nhA = (size_t)HALF * nlda; nhB = (size_t)HALF * nldb; }
        const int nt = cur.nt;
#pragma unroll 1
        for (int t = 0; t < nt; t += 2) {
            const bool last = (t == nt - 2);
            const char* a1 = cA + (size_t)(t + 1) * kstep;
            const char* a2 = last ? nA : cA + (size_t)(t + 2) * kstep; const char* b2 = last ? nB : cB + (size_t)(t + 2) * kstep;
            const char* a3 = a2 + kstep; const char* b3 = b2 + kstep;
            const unsigned xlda = last ? nlda : lda, xldb = last ? nldb : ldb;
            const size_t xhA = last ? nhA : hA, xhB = last ? nhB : hB;
            G_LDB(B0, 0, 0); G_LDB(B1, 0, 1); G_SCHED; G_LDA(At, 0, 0); G_STA(G_SA(1, 1), a1 + hA, lda);
            G_WAIT_V(8); G_WAIT_L(0); G_BAR; G_MMA(0, 0, At, B0); G_MMA(0, 1, At, B1); G_BAR; G_SCHED;
            G_LDA(At, 0, 1); G_STB(G_SB(0, 0), b2, xldb); G_STB(G_SB(0, 1), b2 + xhB, xldb); G_STA(G_SA(0, 0), a2, xlda);
            G_WAIT_V(8); G_WAIT_L(0); G_BAR; G_MMA(1, 0, At, B0); G_MMA(1, 1, At, B1); G_BAR; G_SCHED;
            G_LDB(B0, 1, 0); G_LDB(B1, 1, 1); G_SCHED; G_LDA(At, 1, 0); G_STA(G_SA(0, 1), a2 + xhA, xlda);
            G_WAIT_V(8); G_WAIT_L(0); G_BAR; G_MMA(0, 0, At, B0); G_MMA(0, 1, At, B1); G_BAR; G_SCHED;
            G_LDA(At, 1, 1); G_STB(G_SB(1, 0), b3, xldb); G_STB(G_SB(1, 1), b3 + xhB, xldb); G_STA(G_SA(1, 0), a3, xlda);
            G_WAIT_V(8); G_WAIT_L(0); G_BAR; G_MMA(1, 0, At, B0); G_MMA(1, 1, At, B1); G_BAR; G_SCHED;
        }
        if (wr == 0) G_BAR;
        const bool keep = E(acc, cur, wr, wc, fr, fq);
        if (!has_next) break;
        if (!keep) {
#pragma unroll
            for (int a = 0; a < 2; ++a)
#pragma unroll
                for (int b = 0; b < 2; ++b)
#pragma unroll
                    for (int m = 0; m < 4; ++m)
#pragma unroll
                        for (int n = 0; n < 2; ++n) acc[a][b][m][n] = (f32x4){0.f, 0.f, 0.f, 0.f};
        }
        cur = nxt; cA = nA; cB = nB; lda = nlda; ldb = nldb; hA = nhA; hB = nhB; ++ui;
        if (wr == 1) G_BAR;
    }
    G_WAIT_V(0);
    G_BAR;
#undef G_SA
#undef G_SB
#undef G_STAGE
#undef G_STA
#undef G_STB
#undef G_VO
#undef G_LDA
#undef G_LDB
#undef G_MMA
#undef G_WAIT_V
#undef G_WAIT_L
#undef G_BAR
#undef G_SCHED
}

DI const char* wtp(CParams* p, int l, size_t off) { return (const char*)(p->ws + OFF_WT + (size_t)l * WT_LAYER + off); }
struct SchedZ { static constexpr bool VAR = false;
    TileOrder o; int G, c, mode, l, h; CParams* p;
    DI bool next(int i, Unit& u) const {
        const int L = i * G + c; if (L >= o.nwg) return false;
        int pm, j; o.map(L, pm, j); pm = pm < 32 ? 32 * h + pm : 64 + h;
        const int ct = mode == 0 ? (j < 5 ? j : j + 3) : (j < 3 ? 5 + j : 15 + j);
        u.A = (l == 0 ? (const char*)(p->ws + OFF_SA) : (const char*)p->out) + (size_t)pm * 256 * 2048; u.B = wtp(p, l, WT_IN) + (size_t)ct * 256 * 2048; u.lda = 2048; u.ldb = 2048; u.nt = 16; u.pm = pm; u.pn = ct; u.kind = 0; u.idx = i; return true;
    }
};
struct SchedPool { static constexpr bool VAR = false;
    TileOrder o; int G, c, l, h; CParams* p;
    DI bool next(int i, Unit& u) const {
        const int L = i * G + c; if (L >= o.nwg) return false;
        int pm, g; o.map(L, pm, g); pm += 32 * h;
        u.A = (const char*)(p->ws + OFF_SF) + (size_t)pm * 256 * 2048 + g * 512; u.B = wtp(p, l, WT_PM) + (size_t)g * 256 * 512; u.lda = 2048; u.ldb = 512; u.nt = 4; u.pm = pm; u.pn = g; u.kind = 0; return true;
    }
};
struct SchedMerge { static constexpr bool VAR = false;
    TileOrder o; int G, c, l, h; CParams* p;
    DI bool next(int i, Unit& u) const {
        const int L = (i >> 1) * G + c; if (L >= o.nwg) return false;
        int pm, pn; o.map(L, pm, pn); pm += 32 * h; const int seg = i & 1;
        u.A = (const char*)(p->ws + (seg ? OFF_SC : OFF_SF)) + (size_t)pm * 256 * 2048; u.B = wtp(p, l, seg ? WT_PA : WT_PP) + (size_t)pn * 256 * 2048; u.lda = 2048; u.ldb = 2048; u.nt = 16; u.pm = pm; u.pn = pn; u.kind = seg; return true;
    }
};
struct SchedRes1 { static constexpr bool VAR = true;
    TileOrder o; int G, c, l, h; CParams* p;
    DI bool next(int i, Unit& u) const {
        int L = i * G + c; if (L >= 2 * o.nwg) return false;
        const int kind = L >= o.nwg; if (kind) L -= o.nwg;
        int pm, pn; o.map(L, pm, pn); pm += 32 * h;
        if (!kind) { u.A = (const char*)(p->ws + OFF_SA) + (size_t)pm * 256 * 2048; u.B = wtp(p, l, WT_WO) + (size_t)pn * 256 * 2048; u.lda = 2048; u.ldb = 2048; u.nt = 16; }
        else { u.A = (const char*)(p->ws + OFF_SE) + (size_t)pm * 256 * 512; u.B = wtp(p, l, WT_PLE) + (size_t)pn * 256 * 512; u.lda = 512; u.ldb = 512; u.nt = 4; }
        u.pm = pm; u.pn = pn; u.kind = kind; return true;
    }
};
struct SchedPlain { static constexpr bool VAR = false;
    TileOrder o; int G, c, l, h; CParams* p;
    DI bool next(int i, Unit& u) const {
        const int L = i * G + c; if (L >= o.nwg) return false;
        int pm, pn; o.map(L, pm, pn); pm += 32 * h;
        u.A = (const char*)(p->ws + OFF_SC) + (size_t)pm * 256 * 2048; u.B = wtp(p, l, WT_WG) + (size_t)pn * 256 * 2048; u.lda = 2048; u.ldb = 2048; u.nt = 16; u.pm = pm; u.pn = pn; u.kind = 0; return true;
    }
};

DI float rstd_row(const float* part, int row) {
    const f32x4* q = (const f32x4*)(part + (size_t)row * 32);
    f32x4 t = q[0];
#pragma unroll
    for (int i = 1; i < 8; ++i) t += q[i];
    const float s = (t[0] + t[1]) + (t[2] + t[3]);
    return __builtin_amdgcn_rsqf(s * (1.f / 1024.f) + EPS);
}
DI u32x4 pk8(f32x4 a, f32x4 b) { u32x4 r; r[0] = pk2(a[0], a[1]); r[1] = pk2(a[2], a[3]); r[2] = pk2(b[0], b[1]); r[3] = pk2(b[2], b[3]); return r; }
DI void unpk8(u32x4 u, f32x4& a, f32x4& b) { a[0] = bflo(u[0]); a[1] = bfhi(u[0]); a[2] = bflo(u[1]); a[3] = bfhi(u[1]); b[0] = bflo(u[2]); b[1] = bfhi(u[2]); b[2] = bflo(u[3]); b[3] = bfhi(u[3]); }

template <class Sched>
DI void rstd_table(const Sched& S, const float* part, LAS float* rs) {
    const int tid = tidx();
    Unit u;
    for (int i = 0; i < 8 && S.next(i, u); ++i)
        if (tid < 256) rs[i * 256 + tid] = rstd_row(part, u.pm * 256 + tid);
    __syncthreads();
}
struct EpiZ {
    int l; CParams* p; const LAS float* rs;
    DI bool operator()(Acc& acc, const Unit& u, int wr, int wc, int fr, int fq) const {
        unsigned char* ws = p->ws; float* out = p->out;
        const int ct = u.pn, row0 = u.pm * 256 + wr * 64 + fr, cl0 = wc * 64 + 16 * fq;
        if (ct < 4) {
            const bool special = (u.pm == 31) | (u.pm >= 63);
#pragma unroll
            for (int ai = 0; ai < 2; ++ai)
#pragma unroll
                for (int m = 0; m < 4; ++m) {
                    const int row = row0 + ai * 128 + m * 16; const float rsv = rs[(u.idx & 7) * 256 + (row & 255)];
                    float* po = nullptr;
                    if (special) {
                        if (row >= TP) { const int sb = (row - TP) >> 2, i = row & 3; po = out + O_PS + ((size_t)(l * 128 + sb) * 15 + 11 + i) * 1024; }
                        else { const int t = row & (SEQ - 1), b = row >> 13; if (t >= SEQ - 15) po = out + O_PP + ((size_t)(l * 2 + b) * 15 + (t - (SEQ - 15))) * 1024; }
                    }
#pragma unroll
                    for (int bj = 0; bj < 2; ++bj) {
                        const int col = ct * 256 + cl0 + 8 * bj;
                        const f32x4 v0 = acc[ai][bj][m][0] * rsv, v1 = acc[ai][bj][m][1] * rsv;
                        *(u32x4*)((bf16_t*)(ws + OFF_SB) + (size_t)row * 1024 + col) = pk8(v0, v1);
                        if (po) { *(f32x4*)(po + col) = v0; *(f32x4*)(po + col + 4) = v1; }
                    }
                }
        } else if (ct >= 18) {
            bf16_t* RB = (bf16_t*)(ws + OFF_SB); bf16_t* GB = (bf16_t*)(ws + OFF_SD);
#pragma unroll
            for (int ai = 0; ai < 2; ++ai)
#pragma unroll
                for (int m = 0; m < 4; ++m) {
                    __builtin_amdgcn_sched_barrier(0);
                    const int row = row0 + ai * 128 + m * 16; const float rsv = rs[(u.idx & 7) * 256 + (row & 255)];
                    const size_t off = (size_t)row * 1024 + (ct - 18) * 128 + wc * 32 + 8 * fq;
                    f32x4 r[2], g[2];
#pragma unroll
                    for (int n = 0; n < 2; ++n) {
                        const f32x4 xa = acc[ai][0][m][n] * rsv, xb = acc[ai][1][m][n] * rsv;
#pragma unroll
                        for (int j = 0; j < 4; ++j) { const float ea = 1.f + __expf(-xa[j]), eb = 1.f + __expf(-xb[j]); r[n][j] = eb * __builtin_amdgcn_rcpf(ea); g[n][j] = __builtin_amdgcn_rcpf(eb); }
                    }
                    *(u32x4*)(RB + off) = pk8(r[0], r[1]);
                    *(u32x4*)(GB + off) = pk8(g[0], g[1]);
                }
        } else if (ct < 8 || (ct >= 14)) {
            bf16_t* dst; int ld, cbase; bool silu;
            if (ct < 8) { dst = (bf16_t*)(ws + OFF_SE) + (size_t)(ct - 4) * ((size_t)TT * 256); ld = 256; cbase = 0; silu = true; }
            else { dst = (bf16_t*)(ws + OFF_SD); ld = 1024; cbase = (ct - 14) * 256; silu = true; }
#pragma unroll
            for (int ai = 0; ai < 2; ++ai)
#pragma unroll
                for (int m = 0; m < 4; ++m) {
                    const int row = row0 + ai * 128 + m * 16; const float rsv = rs[(u.idx & 7) * 256 + (row & 255)];
#pragma unroll
                    for (int bj = 0; bj < 2; ++bj) {
                        const int col = cbase + cl0 + 8 * bj;
                        f32x4 v0 = acc[ai][bj][m][0] * rsv, v1 = acc[ai][bj][m][1] * rsv;
#pragma unroll
                        for (int j = 0; j < 4; ++j) { const float s0 = sigmoidf_(v0[j]), s1 = sigmoidf_(v1[j]); v0[j] = silu ? v0[j] * s0 : s0; v1[j] = silu ? v1[j] * s1 : s1; }
                        *(u32x4*)(dst + (size_t)row * ld + col) = pk8(v0, v1);
                    }
                }
        } else if (ct < 13) {
            const bool isk = ct == 12;
            const float* gw = (isk ? p->k_norm_g : p->q_norm_g) + l * 64; const float* rope = (const float*)(ws + OFF_ROPE);
            f32x4 gv[2][2];
#pragma unroll
            for (int bj = 0; bj < 2; ++bj)
#pragma unroll
                for (int n = 0; n < 2; ++n) gv[bj][n] = *(const f32x4*)(gw + 16 * fq + 8 * bj + 4 * n);
            const float osc = isk ? 1.f : 0.125f;
            const int head = isk ? wc : (ct - 8) * 4 + wc;
#pragma unroll
            for (int ai = 0; ai < 2; ++ai)
#pragma unroll
                for (int m = 0; m < 4; ++m) {
                    const int row = row0 + ai * 128 + m * 16; const float rsv = rs[(u.idx & 7) * 256 + (row & 255)];
                    f32x4 v[2][2]; float ss = 0.f;
#pragma unroll
                    for (int bj = 0; bj < 2; ++bj)
#pragma unroll
                        for (int n = 0; n < 2; ++n) { v[bj][n] = acc[ai][bj][m][n] * rsv;
#pragma unroll
                            for (int j = 0; j < 4; ++j) ss += v[bj][n][j] * v[bj][n][j]; }
                    ss += __shfl_xor(ss, 16); ss += __shfl_xor(ss, 32);
                    const float rn = __builtin_amdgcn_rsqf(ss * (1.f / 64.f) + EPS);
#pragma unroll
                    for (int bj = 0; bj < 2; ++bj)
#pragma unroll
                        for (int n = 0; n < 2; ++n) v[bj][n] = v[bj][n] * rn * gv[bj][n];
                    if (fq == 0) {
                        const int pidx = row < TP ? (row & (SEQ - 1)) : SEQ + (row & 3);
                        const f32x4* rp = (const f32x4*)(rope + (size_t)pidx * 16);
                        const f32x4 c0 = rp[0], c1 = rp[1], s0 = rp[2], s1 = rp[3];
                        const f32x4 a0 = v[0][0], a1 = v[0][1], b0 = v[1][0], b1 = v[1][1];
                        v[0][0] = a0 * c0 - b0 * s0; v[0][1] = a1 * c1 - b1 * s1;
                        v[1][0] = b0 * c0 + a0 * s0; v[1][1] = b1 * c1 + a1 * s1;
                    }
                    float* po = nullptr;
                    if (isk) {
                        if (row >= TP) { const int sb = (row - TP) >> 2, i = row & 3; po = out + O_KS + (((size_t)(l * 128 + sb) * 128 + 124 + i) * 4 + wc) * 64; }
                        else { const int t = row & (SEQ - 1), b = row >> 13; if (t >= SEQ - 128) po = out + O_KP + (((size_t)(l * 2 + b) * 128 + (t - (SEQ - 128))) * 4 + wc) * 64; }
                    }
                    bf16_t* dst = isk ? (bf16_t*)(ws + OFF_SE + 2 * PANEL) + (size_t)row * 256 + wc * 64 : (bf16_t*)(ws + OFF_SC) + (size_t)row * 1024 + head * 64;
#pragma unroll
                    for (int bj = 0; bj < 2; ++bj) {
                        const int d = 16 * fq + 8 * bj;
                        if (po) { *(f32x4*)(po + d) = v[bj][0]; *(f32x4*)(po + d + 4) = v[bj][1]; }
                        *(u32x4*)(dst + d) = pk8(v[bj][0] * osc, v[bj][1] * osc);
                    }
                }
        } else {
#pragma unroll
            for (int ai = 0; ai < 2; ++ai)
#pragma unroll
                for (int m = 0; m < 4; ++m) {
                    const int row = row0 + ai * 128 + m * 16; const float rsv = rs[(u.idx & 7) * 256 + (row & 255)];
                    float* po = nullptr;
                    if (row >= TP) { const int sb = (row - TP) >> 2, i = row & 3; po = out + O_VS + ((size_t)(l * 128 + sb) * 128 + 124 + i) * 256; }
                    else { const int t = row & (SEQ - 1), b = row >> 13; if (t >= SEQ - 128) po = out + O_VP + ((size_t)(l * 2 + b) * 128 + (t - (SEQ - 128))) * 256; }
#pragma unroll
                    for (int bj = 0; bj < 2; ++bj) {
                        const int col = cl0 + 8 * bj;
                        const f32x4 v0 = acc[ai][bj][m][0] * rsv, v1 = acc[ai][bj][m][1] * rsv;
                        if (po) { *(f32x4*)(po + col) = v0; *(f32x4*)(po + col + 4) = v1; }
                        *(u32x4*)((bf16_t*)(ws + OFF_SE + 3 * PANEL) + (size_t)row * 256 + col) = pk8(v0, v1);
                    }
                }
        }
        return false;
    }
};

struct EpiPool {
    int l; CParams* p;
    DI bool operator()(Acc& acc, const Unit& u, int wr, int wc, int fr, int fq) const {
        const float* scale = p->pool_scale + l * 1024; const bf16_t* SZP = (const bf16_t*)(p->ws + OFF_SE); bf16_t* YA = (bf16_t*)(p->ws + OFF_SF);
        const int g = u.pn, row0 = u.pm * 256 + wr * 64 + fr, cl0 = wc * 64 + 16 * fq;
        const bf16_t* zp = SZP + (size_t)g * ((size_t)TT * 256);
        f32x4 sc[2][2];
#pragma unroll
        for (int bj = 0; bj < 2; ++bj)
#pragma unroll
            for (int n = 0; n < 2; ++n) sc[bj][n] = *(const f32x4*)(scale + g * 256 + cl0 + 8 * bj + 4 * n);
#pragma unroll
        for (int ai = 0; ai < 2; ++ai)
#pragma unroll
            for (int m = 0; m < 4; ++m) {
                const int row = row0 + ai * 128 + m * 16;
#pragma unroll
                for (int bj = 0; bj < 2; ++bj) {
                    const int cl = cl0 + 8 * bj;
                    f32x4 z0, z1; unpk8(*(const u32x4*)(zp + (size_t)row * 256 + cl), z0, z1);
                    *(u32x4*)(YA + (size_t)row * 1024 + g * 256 + cl) = pk8(acc[ai][bj][m][0] * sc[bj][0] * z0, acc[ai][bj][m][1] * sc[bj][1] * z1);
                }
            }
        return false;
    }
};

struct EpiMerge {
    CParams* p;
    DI bool operator()(Acc& acc, const Unit& u, int wr, int wc, int fr, int fq) const {
        const int row0 = u.pm * 256 + wr * 64 + fr, c0 = u.pn * 256 + wc * 64 + 16 * fq;
        const bf16_t* G = (const bf16_t*)(p->ws + (u.kind == 0 ? OFF_SB : OFF_SD)) + (size_t)row0 * 1024 + c0; bf16_t* M = (bf16_t*)(p->ws + OFF_SA) + (size_t)row0 * 1024 + c0;
        u32x4 buf[2][4];
#pragma unroll
        for (int st = 0; st <= 4; ++st) {
            if (st < 4) {
#pragma unroll
                for (int mm = 0; mm < 2; ++mm)
#pragma unroll
                    for (int bj = 0; bj < 2; ++bj) buf[st & 1][mm * 2 + bj] = *(const u32x4*)(G + (size_t)((st >> 1) * 128 + ((st & 1) * 2 + mm) * 16) * 1024 + 8 * bj);
            }
            __builtin_amdgcn_sched_barrier(0);
            if (st > 0) {
                const int q = st - 1, ai = q >> 1;
#pragma unroll
                for (int mm = 0; mm < 2; ++mm)
#pragma unroll
                    for (int bj = 0; bj < 2; ++bj) {
                        const int m = (q & 1) * 2 + mm;
                        f32x4 g0, g1; unpk8(buf[q & 1][mm * 2 + bj], g0, g1);
                        if (u.kind == 0) { acc[ai][bj][m][0] *= g0; acc[ai][bj][m][1] *= g1; }
                        else *(u32x4*)(M + (size_t)(ai * 128 + m * 16) * 1024 + 8 * bj) = pk8(acc[ai][bj][m][0] * g0, acc[ai][bj][m][1] * g1);
                    }
                __builtin_amdgcn_sched_barrier(0);
            }
        }
        return u.kind == 0;
    }
};

struct EpiRes1 {
    int l; CParams* p;
    DI bool operator()(Acc& acc, const Unit& u, int wr, int wc, int fr, int fq) const {
        const int row0 = u.pm * 256 + wr * 64 + fr, c0 = u.pn * 256 + wc * 64 + 16 * fq;
        if (u.kind != 0) {
            bf16_t* E = (bf16_t*)(p->ws + OFF_SB) + (size_t)row0 * 1024 + c0;
#pragma unroll
            for (int ai = 0; ai < 2; ++ai)
#pragma unroll
                for (int m = 0; m < 4; ++m)
#pragma unroll
                    for (int bj = 0; bj < 2; ++bj) *(u32x4*)(E + (size_t)(ai * 128 + m * 16) * 1024 + 8 * bj) = pk8(acc[ai][bj][m][0], acc[ai][bj][m][1]);
            return false;
        }
        bf16_t* H1B = (bf16_t*)(p->ws + OFF_SC) + (size_t)row0 * 1024 + c0;
        if (l == 0) {
            const float* hin = (row0 < TP ? p->x_prompt + (size_t)row0 * 1024 : p->x_sample + (size_t)(row0 - TP) * 1024) + c0;
            f32x4 buf[2][8];
#pragma unroll
            for (int st = 0; st <= 4; ++st) {
                if (st < 4) {
#pragma unroll
                    for (int mm = 0; mm < 2; ++mm)
#pragma unroll
                        for (int bj = 0; bj < 2; ++bj) { const float* q = hin + (size_t)((st >> 1) * 128 + ((st & 1) * 2 + mm) * 16) * 1024 + 8 * bj; buf[st & 1][(mm * 2 + bj) * 2] = *(const f32x4*)q; buf[st & 1][(mm * 2 + bj) * 2 + 1] = *(const f32x4*)(q + 4); }
                }
                __builtin_amdgcn_sched_barrier(0);
                if (st > 0) {
                    const int q = st - 1, ai = q >> 1;
#pragma unroll
                    for (int mm = 0; mm < 2; ++mm)
#pragma unroll
                        for (int bj = 0; bj < 2; ++bj) { const int m = (q & 1) * 2 + mm;
                            *(u32x4*)(H1B + (size_t)(ai * 128 + m * 16) * 1024 + 8 * bj) = pk8(buf[q & 1][(mm * 2 + bj) * 2] + acc[ai][bj][m][0], buf[q & 1][(mm * 2 + bj) * 2 + 1] + acc[ai][bj][m][1]); }
                    __builtin_amdgcn_sched_barrier(0);
                }
            }
        } else {
            const bf16_t* HB = (const bf16_t*)p->out + (size_t)row0 * 1024 + c0;
            u32x4 buf[2][4];
#pragma unroll
            for (int st = 0; st <= 4; ++st) {
                if (st < 4) {
#pragma unroll
                    for (int mm = 0; mm < 2; ++mm)
#pragma unroll
                        for (int bj = 0; bj < 2; ++bj) buf[st & 1][mm * 2 + bj] = *(const u32x4*)(HB + (size_t)((st >> 1) * 128 + ((st & 1) * 2 + mm) * 16) * 1024 + 8 * bj);
                }
                __builtin_amdgcn_sched_barrier(0);
                if (st > 0) {
                    const int q = st - 1, ai = q >> 1;
#pragma unroll
                    for (int mm = 0; mm < 2; ++mm)
#pragma unroll
                        for (int bj = 0; bj < 2; ++bj) { const int m = (q & 1) * 2 + mm; f32x4 h0, h1; unpk8(buf[q & 1][mm * 2 + bj], h0, h1);
                            *(u32x4*)(H1B + (size_t)(ai * 128 + m * 16) * 1024 + 8 * bj) = pk8(h0 + acc[ai][bj][m][0], h1 + acc[ai][bj][m][1]); }
                    __builtin_amdgcn_sched_barrier(0);
                }
            }
        }
        return false;
    }
};

struct EpiRes2 {
    int l; CParams* p;
    DI bool operator()(Acc& acc, const Unit& u, int wr, int wc, int fr, int fq) const {
        const int row0 = u.pm * 256 + wr * 64 + fr, c0 = u.pn * 256 + wc * 64 + 16 * fq;
        const size_t o0_ = (size_t)row0 * 1024 + c0;
        float* y = p->out + O_Y + o0_; bf16_t* HB = (bf16_t*)p->out + o0_; const bf16_t* H1B = (const bf16_t*)(p->ws + OFF_SC) + o0_; const bf16_t* E = (const bf16_t*)(p->ws + OFF_SB) + o0_;
        float* part = (float*)(p->ws + OFF_PART) + (size_t)row0 * 32 + u.pn * 8 + wc * 2;
        u32x4 bh[2][4], be[2][4];
#pragma unroll
        for (int st = 0; st <= 4; ++st) {
            if (st < 4) {
#pragma unroll
                for (int mm = 0; mm < 2; ++mm)
#pragma unroll
                    for (int bj = 0; bj < 2; ++bj) { const size_t o = (size_t)((st >> 1) * 128 + ((st & 1) * 2 + mm) * 16) * 1024 + 8 * bj; bh[st & 1][mm * 2 + bj] = *(const u32x4*)(H1B + o); be[st & 1][mm * 2 + bj] = *(const u32x4*)(E + o); }
            }
            __builtin_amdgcn_sched_barrier(0);
            if (st > 0) {
                const int q = st - 1, ai = q >> 1;
#pragma unroll
                for (int mm = 0; mm < 2; ++mm) {
                    const int m = (q & 1) * 2 + mm;
                    float ssb[2];
#pragma unroll
                    for (int bj = 0; bj < 2; ++bj) {
                        float ss = 0.f;
                        const size_t o = (size_t)(ai * 128 + m * 16) * 1024 + 8 * bj;
                        f32x4 h0, h1, e0, e1; unpk8(bh[q & 1][mm * 2 + bj], h0, h1); unpk8(be[q & 1][mm * 2 + bj], e0, e1);
                        f32x4 o0, o1;
#pragma unroll
                        for (int j = 0; j < 4; ++j) { o0[j] = h0[j] + sigmoidf_(acc[ai][bj][m][0][j]) * e0[j]; o1[j] = h1[j] + sigmoidf_(acc[ai][bj][m][1][j]) * e1[j]; ss += o0[j] * o0[j] + o1[j] * o1[j]; }
                        if (l == 0) *(u32x4*)(HB + o) = pk8(o0, o1);
                        else { *(f32x4*)(y + o) = o0; *(f32x4*)(y + o + 4) = o1; }
                        ss += __shfl_xor(ss, 16); ss += __shfl_xor(ss, 32);
                        ssb[bj] = ss;
                    }
                    if (fq == 0) *(f32x2*)(part + (size_t)(ai * 128 + m * 16) * 32) = (f32x2){ssb[0], ssb[1]};
                }
                __builtin_amdgcn_sched_barrier(0);
            }
        }
        return false;
    }
};

struct MiniTile { int row0, pn, bj, wc; };
DI MiniTile mini_tile(int mt, int h) { MiniTile t; t.row0 = TP + 256 * h + 64 * (mt & 3); const int cg = mt >> 2; t.pn = cg >> 3; t.bj = (cg >> 2) & 1; t.wc = cg & 3; return t; }
template <int KSTEPS  >
DI void mini_partial(LAS float* red, const bf16_t* A, int lda, const bf16_t* Bt, int ldb, int tid) {
    const int wid = tid >> 6, lane = tid & 63, fr = lane & 15, fq = lane >> 4;
    const int k0 = wid * (32 * KSTEPS) + 8 * fq;
    bf16x8 af[KSTEPS][4], bfr[KSTEPS][2];
#pragma unroll
    for (int s = 0; s < KSTEPS; ++s) {
#pragma unroll
        for (int m = 0; m < 4; ++m) af[s][m] = *(const bf16x8*)(A + (size_t)(16 * m + fr) * lda + k0 + 32 * s);
#pragma unroll
        for (int n = 0; n < 2; ++n) bfr[s][n] = *(const bf16x8*)(Bt + (size_t)(16 * n + fr) * ldb + k0 + 32 * s);
    }
    f32x4 acc[4][2];
#pragma unroll
    for (int m = 0; m < 4; ++m)
#pragma unroll
        for (int n = 0; n < 2; ++n) acc[m][n] = (f32x4){0.f, 0.f, 0.f, 0.f};
#pragma unroll
    for (int s = 0; s < KSTEPS; ++s)
#pragma unroll
        for (int m = 0; m < 4; ++m)
#pragma unroll
            for (int n = 0; n < 2; ++n) acc[m][n] = __builtin_amdgcn_mfma_f32_16x16x32_bf16(bfr[s][n], af[s][m], acc[m][n], 0, 0, 0);
    LAS float* mine = red + wid * 2048;
#pragma unroll
    for (int m = 0; m < 4; ++m)
#pragma unroll
        for (int n = 0; n < 2; ++n) *(LAS f32x4*)(mine + (16 * m + fr) * 32 + 16 * n + 4 * fq) = acc[m][n];
}
DI f32x4 mini_sum(const LAS float* red, int tid) {
    f32x4 s = *(const LAS f32x4*)(red + tid * 4);
#pragma unroll
    for (int w = 1; w < 8; ++w) s += *(const LAS f32x4*)(red + w * 2048 + tid * 4);
    return s;
}
DI void mini_phase(CParams& p, int l, int kind, int c, int G, int h, LAS unsigned char* lds) {
    LAS float* red0 = (LAS float*)lds; LAS float* red1 = red0 + 16384;
    unsigned char* ws = p.ws;
    const unsigned char* wt = ws + OFF_WT + (size_t)l * WT_LAYER;
    for (int mt = c; mt < 128; mt += G) {
        const int tid = tidx();
        const MiniTile t = mini_tile(mt, h);
        const int srow = 128 * t.bj + 32 * t.wc;
        const int row = t.row0 + (tid >> 3), sq = tid & 7;
        const int col = t.pn * 256 + 64 * t.wc + 16 * (sq & 3) + 8 * t.bj + 4 * (sq >> 2);
        __syncthreads();
        if (kind == 3) {
            const bf16_t* A = (const bf16_t*)(ws + OFF_SF) + (size_t)t.row0 * 1024 + t.pn * 256;
            const bf16_t* B = (const bf16_t*)(wt + WT_PM) + (size_t)(t.pn * 256 + srow) * 256;
            mini_partial<1>(red0, A, 1024, B, 256, tid);
            __syncthreads();
            const f32x4 v = mini_sum(red0, tid);
            const f32x4 sc = *(const f32x4*)(p.pool_scale + l * 1024 + col);
            const f32x4 z = unpk4(*(const u32x2*)((const bf16_t*)(ws + OFF_SE) + (size_t)t.pn * ((size_t)TT * 256) + (size_t)row * 256 + (col & 255)));
            *(u32x2*)((bf16_t*)(ws + OFF_YAS) + (size_t)(row - TP) * 1024 + col) = pk4(v * sc * z);
        } else if (kind == 4) {
            mini_partial<4>(red0, (const bf16_t*)(ws + OFF_YAS) + (size_t)(t.row0 - TP) * 1024, 1024, (const bf16_t*)(wt + WT_PP) + (size_t)(t.pn * 256 + srow) * 1024, 1024, tid);
            mini_partial<4>(red1, (const bf16_t*)(ws + OFF_SC) + (size_t)t.row0 * 1024, 1024, (const bf16_t*)(wt + WT_PA) + (size_t)(t.pn * 256 + srow) * 1024, 1024, tid);
            __syncthreads();
            const f32x4 a = mini_sum(red0, tid), b = mini_sum(red1, tid);
            const size_t off = (size_t)row * 1024 + col;
            const f32x4 ga = unpk4(*(const u32x2*)((const bf16_t*)(ws + OFF_SB) + off)), gb = unpk4(*(const u32x2*)((const bf16_t*)(ws + OFF_SD) + off));
            *(u32x2*)((bf16_t*)(ws + OFF_SA) + off) = pk4(gb * (ga * a + b));
        } else if (kind == 5) {
            mini_partial<4>(red0, (const bf16_t*)(ws + OFF_SA) + (size_t)t.row0 * 1024, 1024, (const bf16_t*)(wt + WT_WO) + (size_t)(t.pn * 256 + srow) * 1024, 1024, tid);
            mini_partial<1>(red1, (const bf16_t*)(ws + OFF_SE) + (size_t)t.row0 * 256, 256, (const bf16_t*)(wt + WT_PLE) + (size_t)(t.pn * 256 + srow) * 256, 256, tid);
            __syncthreads();
            const f32x4 a = mini_sum(red0, tid), e = mini_sum(red1, tid);
            const size_t off = (size_t)row * 1024 + col;
            const f32x4 hin = l == 0 ? *(const f32x4*)(p.x_sample + (size_t)(row - TP) * 1024 + col) : unpk4(*(const u32x2*)((const bf16_t*)p.out + off));
            const f32x4 h1 = hin + a;
            *(u32x2*)((bf16_t*)(ws + OFF_SC) + off) = pk4(h1);
            *(u32x2*)((bf16_t*)(ws + OFF_SB) + off) = pk4(e);
        } else {
            mini_partial<4>(red0, (const bf16_t*)(ws + OFF_SC) + (size_t)t.row0 * 1024, 1024, (const bf16_t*)(wt + WT_WG) + (size_t)(t.pn * 256 + srow) * 1024, 1024, tid);
            __syncthreads();
            const f32x4 a = mini_sum(red0, tid);
            const size_t off = (size_t)row * 1024 + col;
            const f32x4 h1 = unpk4(*(const u32x2*)((const bf16_t*)(ws + OFF_SC) + off));
            const f32x4 e = unpk4(*(const u32x2*)((const bf16_t*)(ws + OFF_SB) + off));
            f32x4 h2; float ss = 0.f;
#pragma unroll
            for (int j = 0; j < 4; ++j) { h2[j] = h1[j] + sigmoidf_(a[j]) * e[j]; ss += h2[j] * h2[j]; }
            if (l == 0) *(u32x2*)((bf16_t*)p.out + off) = pk4(h2);
            else *(f32x4*)(p.out + O_Y + off) = h2;
            ss += __shfl_xor(ss, 1); ss += __shfl_xor(ss, 2); ss += __shfl_xor(ss, 4);
            if (sq == 0) ((float*)(ws + OFF_PART))[(size_t)row * 32 + t.pn * 8 + t.wc * 2 + t.bj] = ss;
        }
    }
}

struct WtDesc { const float* src; const float* gscale; bf16_t* dst; int ld_src, ld_dst, k0, c0; };
DI WtDesc wt_desc(CParams& p, int it) {
    WtDesc d; const int l = it / 2816; int r = it % 2816;
    unsigned char* wt = p.ws + OFF_WT + (size_t)l * WT_LAYER;
    d.gscale = nullptr;
    if (r < 1664) { const int kt = r / 104, ctile = r % 104;
        d.src = p.w_in + (size_t)l * 1024 * NCOL; d.ld_src = NCOL; d.k0 = kt * 64; d.c0 = ctile * 64; d.dst = (bf16_t*)(wt + WT_IN); d.ld_dst = 1024; d.gscale = p.norm_g + l * 1024;
    } else if ((r -= 1664) < 64) { const int g = r >> 4, kt = (r >> 2) & 3, ctile = r & 3;
        d.src = p.pool_map + (size_t)(l * 4 + g) * 65536; d.ld_src = 256; d.k0 = kt * 64; d.c0 = ctile * 64; d.dst = (bf16_t*)(wt + WT_PM) + (size_t)g * 65536; d.ld_dst = 256;
    } else if ((r -= 64) < 1024) { const int w = r >> 8, kt = (r >> 4) & 15, ctile = r & 15;
        d.src = (w == 0 ? p.w_proj_pool : w == 1 ? p.w_proj_attn : w == 2 ? p.w_out : p.w_ple_gate) + (size_t)l * 1048576;
        d.dst = (bf16_t*)(wt + (w == 0 ? WT_PP : w == 1 ? WT_PA : w == 2 ? WT_WO : WT_WG)); d.ld_src = 1024; d.ld_dst = 1024; d.k0 = kt * 64; d.c0 = ctile * 64;
    } else { r -= 1024; const int kt = r >> 4, ctile = r & 15;
        d.src = p.w_ple + (size_t)l * 262144; d.ld_src = 1024; d.k0 = kt * 64; d.c0 = ctile * 64; d.dst = (bf16_t*)(wt + WT_PLE); d.ld_dst = 256;
    }
    return d;
}
DI void wt_load(const WtDesc& d, int tid, f32x4& v0, f32x4& v1) {
    const int kk = tid >> 4, c4 = (tid & 15) * 4;
    v0 = __builtin_nontemporal_load((const f32x4*)(d.src + (size_t)(d.k0 + kk) * d.ld_src + d.c0 + c4));
    v1 = __builtin_nontemporal_load((const f32x4*)(d.src + (size_t)(d.k0 + kk + 32) * d.ld_src + d.c0 + c4));
    if (d.gscale) { v0 *= d.gscale[d.k0 + kk]; v1 *= d.gscale[d.k0 + kk + 32]; }
}

DI void phase0(CParams& p, LAS unsigned char* lds, int h, int bid, int G) {
    const int tid = tidx();
    LAS float* tile = (LAS float*)lds;
    {
        const int it_end = h == 0 ? 1664 : 2 * 2816;
        int it = (h == 0 ? 0 : 1664) + bid;
        WtDesc d = wt_desc(p, it < it_end ? it : 0);
        f32x4 v0, v1; wt_load(d, tid, v0, v1);
        for (; it < it_end; it += G) {
            const int nit = it + G < it_end ? it + G : it;
            const WtDesc dn = wt_desc(p, nit);
            f32x4 n0, n1; wt_load(dn, tid, n0, n1);
            __syncthreads();
            { const int kk = tid >> 4, c4 = (tid & 15) * 4;
#pragma unroll
              for (int j = 0; j < 4; ++j) { tile[(c4 + j) * 65 + kk] = v0[j]; tile[(c4 + j) * 65 + kk + 32] = v1[j]; } }
            __syncthreads();
            { const int cc = tid >> 3, ks = (tid & 7) * 8;
              int c = d.c0 + cc;
              if (d.gscale && c >= 4608) {
                  const int gcol = (c - 4608) & 1023, isb = (c - 4608) >> 10, lc = gcol & 127;
                  c = (18 + (gcol >> 7)) * 256 + 128 * isb + 32 * (lc >> 5) + 16 * ((lc >> 2) & 1) + 4 * ((lc >> 3) & 3) + (lc & 3);
              } else { const int a = c & 255; c = (c & ~255) + (128 * ((a >> 3) & 1) + 32 * (a >> 6) + 16 * ((a >> 2) & 1) + 4 * ((a >> 4) & 3) + (a & 3)); }
              u32x4 o;
              o[0] = pk2(tile[cc * 65 + ks + 0], tile[cc * 65 + ks + 1]); o[1] = pk2(tile[cc * 65 + ks + 2], tile[cc * 65 + ks + 3]);
              o[2] = pk2(tile[cc * 65 + ks + 4], tile[cc * 65 + ks + 5]); o[3] = pk2(tile[cc * 65 + ks + 6], tile[cc * 65 + ks + 7]);
              *(u32x4*)(d.dst + (size_t)c * d.ld_dst + d.k0 + ks) = o; }
            d = dn; v0 = n0; v1 = n1;
        }
    }
    {
        bf16_t* XB = (bf16_t*)(p.ws + OFF_SA); float* part = (float*)(p.ws + OFF_PART);
        const int wid = tid >> 6, lane = tid & 63;
        for (int rl0 = bid * 8 + wid; rl0 < 8448; rl0 += 2 * G * 8) {
            const int rlb = rl0 + G * 8; const bool hasb = rlb < 8448; const int rl1 = hasb ? rlb : rl0;
            const int row0 = rl0 < 8192 ? 8192 * h + rl0 : TP + 256 * h + (rl0 - 8192), row1 = rl1 < 8192 ? 8192 * h + rl1 : TP + 256 * h + (rl1 - 8192);
            const float* s0 = row0 < TP ? p.x_prompt + (size_t)row0 * 1024 : p.x_sample + (size_t)(row0 - TP) * 1024;
            const float* s1 = row1 < TP ? p.x_prompt + (size_t)row1 * 1024 : p.x_sample + (size_t)(row1 - TP) * 1024;
            f32x4 a[4], b[4];
#pragma unroll
            for (int j = 0; j < 4; ++j) { a[j] = __builtin_nontemporal_load((const f32x4*)(s0 + j * 256 + lane * 4)); b[j] = __builtin_nontemporal_load((const f32x4*)(s1 + j * 256 + lane * 4)); }
            float sa = 0.f, sb = 0.f;
#pragma unroll
            for (int j = 0; j < 4; ++j) {
                sa += a[j][0] * a[j][0] + a[j][1] * a[j][1] + a[j][2] * a[j][2] + a[j][3] * a[j][3];
                sb += b[j][0] * b[j][0] + b[j][1] * b[j][1] + b[j][2] * b[j][2] + b[j][3] * b[j][3];
                *(u32x2*)(XB + (size_t)row0 * 1024 + j * 256 + lane * 4) = pk4(a[j]);
                if (hasb) *(u32x2*)(XB + (size_t)row1 * 1024 + j * 256 + lane * 4) = pk4(b[j]);
            }
#pragma unroll
            for (int o = 32; o >= 1; o >>= 1) { sa += __shfl_xor(sa, o); sb += __shfl_xor(sb, o); }
            if (lane < 32) { part[(size_t)row0 * 32 + lane] = lane == 0 ? sa : 0.f; if (hasb) part[(size_t)row1 * 32 + lane] = lane == 0 ? sb : 0.f; }
        }
    }
    {
        float* rope = (float*)(p.ws + OFF_ROPE);
        for (int idx = bid * 512 + tid; h == 0 && idx < 8196 * 8; idx += G * 512) {
            const int pi = idx >> 3, i = idx & 7;
            const int pos = pi < SEQ ? pi : 16384 + (pi - SEQ);
            const float angf = (float)pos * p.inv_freq[i];
            const double tt = (double)angf * 0.15915494309189533577;
            const float fr = (float)(tt - __builtin_floor(tt));
            rope[(size_t)pi * 16 + i] = __builtin_amdgcn_cosf(fr);
            rope[(size_t)pi * 16 + 8 + i] = __builtin_amdgcn_sinf(fr);
        }
    }
}

DI int crow(int reg, int h) { return (reg & 3) + 8 * (reg >> 2) + 4 * h; }
#define MFMA32(a, b, c) __builtin_amdgcn_mfma_f32_32x32x16_bf16((a), (b), (c), 0, 0, 0)

DI void attn_prompt_item(CParams& p, int l, int item, LAS unsigned char* lds) {
    const int tid = tidx(), wid = tid >> 6, lane = tid & 63;
    const int kh = item & 3, nb = (item >> 2) & 63, b = item >> 8;
    bf16_t* Q = (bf16_t*)(p.ws + OFF_SC);
    const bf16_t* KB = (const bf16_t*)(p.ws + OFF_SE + 2 * PANEL);
    const bf16_t* VB = (const bf16_t*)(p.ws + OFF_SE + 3 * PANEL);
    const bf16_t* SZA = (const bf16_t*)(p.ws + OFF_SD);
    LAS unsigned char* Ks = lds; LAS unsigned char* Vt = lds + 36864;
    __syncthreads();
    const long tk0 = (long)b * SEQ + 128 * (nb - 1);
#pragma unroll
    for (int e = 0; e < 4; ++e) {
        const int idx = tid + 512 * e, key = idx >> 3, seg = idx & 7;
        u32x4 v = {0u, 0u, 0u, 0u};
        if (nb > 0 || key >= 128) v = *(const u32x4*)(KB + (size_t)(tk0 + key) * 256 + kh * 64 + seg * 8);
        *(LAS u32x4*)(Ks + key * 144 + seg * 16) = v;
    }
    {
        const int key = tid & 255, half = tid >> 8; const bool ok = nb > 0 || key >= 128;
#pragma unroll
        for (int e = 0; e < 4; ++e) {
            u32x4 v = {0u, 0u, 0u, 0u};
            if (ok) v = *(const u32x4*)(VB + (size_t)(tk0 + key) * 256 + kh * 64 + half * 32 + e * 8);
#pragma unroll
            for (int jj = 0; jj < 4; ++jj) {
                const int d = half * 32 + e * 8 + 2 * jj;
                *(LAS unsigned short*)(Vt + d * 528 + key * 2) = (unsigned short)(v[jj] & 0xffffu);
                *(LAS unsigned short*)(Vt + (d + 1) * 528 + key * 2) = (unsigned short)(v[jj] >> 16);
            }
        }
    }
    __syncthreads();
    const int g = wid >> 1, rh = wid & 1, h = kh * 4 + g, r = lane & 31, hh = lane >> 5;
    const float sink = p.sinks[l * 16 + h];
    const float NEG = -__builtin_inff();
#pragma unroll 1
    for (int sbk = 0; sbk < 2; ++sbk) {
        const int wq = 2 * rh + sbk;
        const size_t tq = (size_t)b * SEQ + 128 * nb + 32 * wq + r;
        bf16x8 qf[4];
#pragma unroll
        for (int s = 0; s < 4; ++s) qf[s] = *(const bf16x8*)(Q + tq * 1024 + h * 64 + 16 * s + 8 * hh);
        f32x16 st[5];
#pragma unroll
        for (int kt = 0; kt < 5; ++kt) {
            const int jb = 32 * (wq + kt);
            f32x16 a;
#pragma unroll
            for (int i = 0; i < 16; ++i) a[i] = 0.f;
#pragma unroll
            for (int s = 0; s < 4; ++s) {
                const bf16x8 kf = *(const LAS bf16x8*)(Ks + (jb + r) * 144 + (16 * s + 8 * hh) * 2);
                a = MFMA32(kf, qf[s], a);
            }
            st[kt] = a;
        }
#pragma unroll
        for (int i = 0; i < 16; ++i) {
            const int kr = crow(i, hh);
            if (kr < r) st[0][i] = NEG;
            if (kr > r) st[4][i] = NEG;
        }
        if (nb == 0) {
#pragma unroll
            for (int kt = 0; kt < 4; ++kt)
                if (wq + kt < 4) {
#pragma unroll
                    for (int i = 0; i < 16; ++i) st[kt][i] = NEG;
                }
        }
        float mx = sink;
#pragma unroll
        for (int kt = 0; kt < 5; ++kt)
#pragma unroll
            for (int i = 0; i < 16; ++i) mx = fmaxf(mx, st[kt][i]);
        mx = fmaxf(mx, __shfl_xor(mx, 32));
        float sum = 0.f;
#pragma unroll
        for (int kt = 0; kt < 5; ++kt)
#pragma unroll
            for (int i = 0; i < 16; ++i) { const float e = __expf(st[kt][i] - mx); st[kt][i] = e; sum += e; }
        sum += __shfl_xor(sum, 32);
        sum += __expf(sink - mx);
        const float inv = 1.f / sum;
        f32x16 o0, o1;
#pragma unroll
        for (int i = 0; i < 16; ++i) { o0[i] = 0.f; o1[i] = 0.f; }
#pragma unroll
        for (int kt = 0; kt < 5; ++kt) {
            const int jb = 32 * (wq + kt);
#pragma unroll
            for (int s2 = 0; s2 < 2; ++s2) {
                u32x4 pw;
                pw[0] = pk2(st[kt][8 * s2 + 0], st[kt][8 * s2 + 1]); pw[1] = pk2(st[kt][8 * s2 + 2], st[kt][8 * s2 + 3]);
                pw[2] = pk2(st[kt][8 * s2 + 4], st[kt][8 * s2 + 5]); pw[3] = pk2(st[kt][8 * s2 + 6], st[kt][8 * s2 + 7]);
                const bf16x8 xs = __builtin_bit_cast(bf16x8, pw);
                const int ko = (jb + 16 * s2 + 4 * hh) * 2;
                const s16x4 v0a = *(const LAS s16x4*)(Vt + r * 528 + ko), v0b = *(const LAS s16x4*)(Vt + r * 528 + ko + 16);
                const s16x4 v1a = *(const LAS s16x4*)(Vt + (r + 32) * 528 + ko), v1b = *(const LAS s16x4*)(Vt + (r + 32) * 528 + ko + 16);
                const bf16x8 vf0 = __builtin_shufflevector(v0a, v0b, 0, 1, 2, 3, 4, 5, 6, 7), vf1 = __builtin_shufflevector(v1a, v1b, 0, 1, 2, 3, 4, 5, 6, 7);
                o0 = MFMA32(vf0, xs, o0); o1 = MFMA32(vf1, xs, o1);
            }
        }
#pragma unroll
        for (int g4 = 0; g4 < 4; ++g4) {
            const int d0 = 8 * g4 + 4 * hh;
            {
                const size_t off = tq * 1024 + h * 64 + d0;
                const f32x4 z = unpk4(*(const u32x2*)(SZA + off));
                f32x4 v; v[0] = o0[4 * g4] * inv * z[0]; v[1] = o0[4 * g4 + 1] * inv * z[1]; v[2] = o0[4 * g4 + 2] * inv * z[2]; v[3] = o0[4 * g4 + 3] * inv * z[3];
                *(u32x2*)(Q + off) = pk4(v);
            }
            {
                const size_t off = tq * 1024 + h * 64 + 32 + d0;
                const f32x4 z = unpk4(*(const u32x2*)(SZA + off));
                f32x4 v; v[0] = o1[4 * g4] * inv * z[0]; v[1] = o1[4 * g4 + 1] * inv * z[1]; v[2] = o1[4 * g4 + 2] * inv * z[2]; v[3] = o1[4 * g4 + 3] * inv * z[3];
                *(u32x2*)(Q + off) = pk4(v);
            }
        }
    }
}

DI void attn_sample_item(CParams& p, int l, int item, LAS unsigned char* lds) {
    const int tid = tidx(), wid = tid >> 6, lane = tid & 63;
    const int sb = item >> 1, h = (item & 1) * 8 + wid, kh = h >> 2;
    bf16_t* Q = (bf16_t*)(p.ws + OFF_SC);
    const bf16_t* KB = (const bf16_t*)(p.ws + OFF_SE + 2 * PANEL);
    const bf16_t* VB = (const bf16_t*)(p.ws + OFF_SE + 3 * PANEL);
    const bf16_t* SZA = (const bf16_t*)(p.ws + OFF_SD);
    LAS float* wq_ = (LAS float*)(lds + wid * 4096);
    LAS float* sc = wq_ + 256;
    const size_t tq0 = (size_t)TP + 4 * sb;
    const float sink = p.sinks[l * 16 + h];
    __syncthreads();
#pragma unroll
    for (int i = 0; i < 4; ++i) wq_[i * 64 + lane] = bf1(Q[(tq0 + i) * 1024 + h * 64 + lane]);
    __syncthreads();
    const int kq = lane >> 4, ds = lane & 15;
    f32x4 qv[4];
#pragma unroll
    for (int i = 0; i < 4; ++i) qv[i] = *(const LAS f32x4*)(wq_ + i * 64 + ds * 4);
    const size_t cbase = ((size_t)(l * 128 + sb) * 128 * 4 + kh) * 64;
    const float* ck = p.cache_k + cbase + ds * 4; const float* cv = p.cache_v + cbase + ds * 4;
#pragma unroll 1
    for (int it0 = 0; it0 < 32; it0 += 8) {
        f32x4 kv[8];
#pragma unroll
        for (int u = 0; u < 8; ++u) kv[u] = *(const f32x4*)(ck + (size_t)(4 * (it0 + u) + kq) * 256);
#pragma unroll
        for (int u = 0; u < 8; ++u) {
            const int c = 4 * (it0 + u) + kq;
            float d[4];
#pragma unroll
            for (int i = 0; i < 4; ++i) {
                float x = kv[u][0] * qv[i][0] + kv[u][1] * qv[i][1] + kv[u][2] * qv[i][2] + kv[u][3] * qv[i][3];
                x += __shfl_xor(x, 1); x += __shfl_xor(x, 2); x += __shfl_xor(x, 4); x += __shfl_xor(x, 8);
                d[i] = x;
            }
            const float my = ds == 0 ? d[0] : ds == 1 ? d[1] : ds == 2 ? d[2] : d[3];
            if (ds < 4) sc[c * 4 + ds] = my;
        }
    }
    {
        const f32x4 kv = unpk4(*(const u32x2*)(KB + (tq0 + kq) * 256 + kh * 64 + ds * 4));
        float d[4];
#pragma unroll
        for (int i = 0; i < 4; ++i) {
            float x = kv[0] * qv[i][0] + kv[1] * qv[i][1] + kv[2] * qv[i][2] + kv[3] * qv[i][3];
            x += __shfl_xor(x, 1); x += __shfl_xor(x, 2); x += __shfl_xor(x, 4); x += __shfl_xor(x, 8);
            d[i] = x;
        }
        const float my = ds == 0 ? d[0] : ds == 1 ? d[1] : ds == 2 ? d[2] : d[3];
        if (ds < 4) sc[(128 + kq) * 4 + ds] = my;
    }
    __syncthreads();
#pragma unroll
    for (int i = 0; i < 4; ++i) {
        const float NEG = -__builtin_inff();
        float s0 = sc[lane * 4 + i], s1 = sc[(lane + 64) * 4 + i], s2 = lane < 4 ? sc[(128 + lane) * 4 + i] : NEG;
        if (lane < i) s0 = NEG;
        if (lane > i) s2 = NEG;
        float mx = fmaxf(fmaxf(s0, s1), fmaxf(s2, sink));
#pragma unroll
        for (int o = 32; o >= 1; o >>= 1) mx = fmaxf(mx, __shfl_xor(mx, o));
        const float e0 = __expf(s0 - mx), e1 = __expf(s1 - mx), e2 = __expf(s2 - mx);
        float sum = e0 + e1 + e2;
#pragma unroll
        for (int o = 32; o >= 1; o >>= 1) sum += __shfl_xor(sum, o);
        sum += __expf(sink - mx);
        const float inv = 1.f / sum;
        sc[lane * 4 + i] = e0 * inv; sc[(lane + 64) * 4 + i] = e1 * inv; if (lane < 4) sc[(128 + lane) * 4 + i] = e2 * inv;
    }
    __syncthreads();
    f32x4 o[4];
#pragma unroll
    for (int i = 0; i < 4; ++i) o[i] = (f32x4){0.f, 0.f, 0.f, 0.f};
#pragma unroll 1
    for (int it0 = 0; it0 < 32; it0 += 8) {
        f32x4 vv[8];
#pragma unroll
        for (int u = 0; u < 8; ++u) vv[u] = *(const f32x4*)(cv + (size_t)(4 * (it0 + u) + kq) * 256);
#pragma unroll
        for (int u = 0; u < 8; ++u) {
            const f32x4 pr = *(const LAS f32x4*)(sc + (4 * (it0 + u) + kq) * 4);
#pragma unroll
            for (int i = 0; i < 4; ++i) o[i] += vv[u] * pr[i];
        }
    }
    {
        const f32x4 vv = unpk4(*(const u32x2*)(VB + (tq0 + kq) * 256 + kh * 64 + ds * 4));
        const f32x4 pr = *(const LAS f32x4*)(sc + (128 + kq) * 4);
#pragma unroll
        for (int i = 0; i < 4; ++i) o[i] += vv * pr[i];
    }
#pragma unroll
    for (int i = 0; i < 4; ++i)
#pragma unroll
        for (int j = 0; j < 4; ++j) { float x = o[i][j]; x += __shfl_xor(x, 16); x += __shfl_xor(x, 32); o[i][j] = x; }
    {
        const f32x4 mine = kq == 0 ? o[0] : kq == 1 ? o[1] : kq == 2 ? o[2] : o[3];
        const size_t off = (tq0 + kq) * 1024 + h * 64 + ds * 4;
        const f32x4 z = unpk4(*(const u32x2*)(SZA + off));
        *(u32x2*)(Q + off) = pk4(mine * z);
    }
}

template <int W>
DI void pool_prompt_body(const bf16_t* U, bf16_t* R, int t0) {
    f32x2 prev[16], cur[16];
#pragma unroll
    for (int j = 0; j < 16; ++j) {
        prev[j] = (f32x2){0.f, 0.f};
        if (j >= 17 - W) { const int t = t0 - 16 + j; if (t >= 0) { const unsigned u = *(const unsigned*)(U + (size_t)t * 1024); prev[j] = (f32x2){bflo(u), bfhi(u)}; } }
    }
#pragma unroll 1
    for (int ch = 0; ch < 4; ++ch) {
        const int tb = t0 + ch * 16;
#pragma unroll
        for (int j = 0; j < 16; ++j) { const unsigned u = *(const unsigned*)(U + (size_t)(tb + j) * 1024); cur[j] = (f32x2){bflo(u), bfhi(u)}; }
#pragma unroll
        for (int i = 0; i < 16; ++i) {
            f32x2 sum = cur[i];
#pragma unroll
            for (int j = 1; j < W; ++j) sum += (i - j >= 0) ? cur[i - j >= 0 ? i - j : 0] : prev[i - j >= 0 ? 0 : 16 + i - j];
            const int t = tb + i;
            const float ic = 1.f / (float)(t + 1 < W ? t + 1 : W);
            const f32x2 r = sum * ic - cur[i];
            *(unsigned*)(R + (size_t)t * 1024) = pk2(r[0], r[1]);
        }
#pragma unroll
        for (int j = 0; j < 16; ++j) prev[j] = cur[j];
    }
}

DI void pool_prompt_item(CParams& p, int item) {
    const int tid = tidx(), g = __builtin_amdgcn_readfirstlane(tid >> 7);
    const int b = item >> 7, t0 = (item & 127) * 64;
    const bf16_t* U = (const bf16_t*)(p.ws + OFF_SB) + (size_t)b * SEQ * 1024 + 2 * tid;
    bf16_t* R = (bf16_t*)(p.ws + OFF_SF) + (size_t)b * SEQ * 1024 + 2 * tid;
    if (g == 0) pool_prompt_body<2>(U, R, t0);
    else if (g == 1) pool_prompt_body<4>(U, R, t0);
    else if (g == 2) pool_prompt_body<8>(U, R, t0);
    else pool_prompt_body<16>(U, R, t0);
}

DI void pool_sample_item(CParams& p, int l, int item) {
    const int tid = tidx(), g = tid >> 7;
    const float iw = g == 0 ? 0.5f : g == 1 ? 0.25f : g == 2 ? 0.125f : 0.0625f;
    {
        const int sb = item;
        const float* st = p.state_pool + (size_t)(l * 128 + sb) * 15 * 1024 + 2 * tid;
        float* np = p.out + O_PS + (size_t)(l * 128 + sb) * 15 * 1024 + 2 * tid;
        const bf16_t* U = (const bf16_t*)(p.ws + OFF_SB) + ((size_t)TP + 4 * sb) * 1024 + 2 * tid;
        bf16_t* R = (bf16_t*)(p.ws + OFF_SF) + ((size_t)TP + 4 * sb) * 1024 + 2 * tid;
        f32x2 pv[19], cs[20];
#pragma unroll
        for (int j = 0; j < 15; ++j) pv[j] = *(const f32x2*)(st + (size_t)j * 1024);
#pragma unroll
        for (int j = 0; j < 4; ++j) { const unsigned u = *(const unsigned*)(U + (size_t)j * 1024); pv[15 + j] = (f32x2){bflo(u), bfhi(u)}; }
#pragma unroll
        for (int j = 4; j < 15; ++j) *(f32x2*)(np + (size_t)(j - 4) * 1024) = pv[j];
        cs[0] = (f32x2){0.f, 0.f};
#pragma unroll
        for (int j = 0; j < 19; ++j) cs[j + 1] = cs[j] + pv[j];
#pragma unroll
        for (int i = 0; i < 4; ++i) {
            const f32x2 start = g == 0 ? cs[14 + i] : g == 1 ? cs[12 + i] : g == 2 ? cs[8 + i] : cs[i];
            const f32x2 r = (cs[16 + i] - start) * iw - pv[15 + i];
            *(unsigned*)(R + (size_t)i * 1024) = pk2(r[0], r[1]);
        }
    }
}

DI void cache_copy_item(CParams& p, int l, int item) {
    const int tid = tidx(), sb = item >> 1;
    const size_t base = (size_t)(l * 128 + sb) * 128 * 256;
    const f32x4* src = (const f32x4*)(((item & 1) ? p.cache_v : p.cache_k) + base + 4 * 256) + tid;
    f32x4* dst = (f32x4*)(p.out + ((item & 1) ? O_VS : O_KS) + base) + tid;
#pragma unroll 1
    for (int i0 = 0; i0 < 15; i0 += 5) {
        f32x4 v[5];
#pragma unroll
        for (int u = 0; u < 5; ++u) v[u] = __builtin_nontemporal_load(src + (size_t)(i0 + u) * 512);
#pragma unroll
        for (int u = 0; u < 5; ++u) __builtin_nontemporal_store(v[u], dst + (size_t)(i0 + u) * 512);
    }
    if (tid < 256) { const f32x4 v = __builtin_nontemporal_load(src + (size_t)15 * 512); __builtin_nontemporal_store(v, dst + (size_t)15 * 512); }
}

DI void phase2(CParams& p, int l, LAS unsigned char* lds, int h, int c, int G) {
    for (int it = c; it < 704; it += G) {
        if (it < 128) attn_sample_item(p, l, 128 * h + it, lds);
        else if (it < 384) attn_prompt_item(p, l, (h << 8) | (it - 128), lds);
        else if (it < 512) cache_copy_item(p, l, 128 * h + (it - 384));
        else if (it < 640) pool_prompt_item(p, 128 * h + (it - 512));
        else pool_sample_item(p, l, 64 * h + (it - 640));
    }
}

DI void convert_p(CParams& p, int l, int h, int c, int G) {
    bf16_t* PB = (bf16_t*)(p.ws + OFF_SE);
    const size_t n8 = (size_t)(8192 + 256) * 256 / 8;
    for (size_t i = (size_t)c * 512 + tidx(); i < n8; i += (size_t)G * 512) {
        const size_t el = i * 8, e = el < (size_t)8192 * 256 ? (size_t)h * 8192 * 256 + el : (size_t)TP * 256 + (size_t)h * 256 * 256 + (el - (size_t)8192 * 256);
        const float* src = e < (size_t)TP * 256 ? p.p_prompt + (size_t)l * TP * 256 + e : p.p_sample + (size_t)l * TS * 256 + (e - (size_t)TP * 256);
        const f32x4 a = __builtin_nontemporal_load((const f32x4*)src), b = __builtin_nontemporal_load((const f32x4*)(src + 4));
        u32x4 o; o[0] = pk2(a[0], a[1]); o[1] = pk2(a[2], a[3]); o[2] = pk2(b[0], b[1]); o[3] = pk2(b[2], b[3]);
        *(u32x4*)(PB + e) = o;
    }
}

#define XB_TMO      128
#define XB_XCNT(j)  (256  + 64 * (j))
#define XB_XSUB(j)  (1280 + 64 * (j))
#define XB_XGEN(j)  (2304 + 64 * (j))
#define XB_TOP      3328
#define XB_TOPGEN   3392
#define XCD_BAR_WORDS 3456
#define XB_SPIN_CAP (1u << 20)
DI unsigned xb_ld(unsigned* p) { return __hip_atomic_load(p, __ATOMIC_RELAXED, __HIP_MEMORY_SCOPE_AGENT); }
DI unsigned xb_add(unsigned* p, unsigned v) { return __hip_atomic_fetch_add(p, v, __ATOMIC_RELAXED, __HIP_MEMORY_SCOPE_AGENT); }
DI unsigned xb_xcc_id() { return (unsigned)__builtin_amdgcn_s_getreg((3 << 11) | 20) & 0xFu; }
#define XB_SPIN(cond, bar) do { unsigned _sp = 0; while (cond) { __builtin_amdgcn_s_sleep(1); \
    if ((++_sp & 255u) == 0u) { if (xb_ld(&(bar)[XB_TMO])) break; if (_sp > XB_SPIN_CAP) { atomicAdd(&(bar)[XB_TMO], 1u); break; } } } } while (0)
struct XcdBarrier { unsigned* bar; unsigned x; volatile LAS unsigned* st; unsigned total; };
DI XcdBarrier xcd_barrier_post(unsigned* bar, volatile LAS unsigned* st, unsigned total) {
    XcdBarrier b; b.bar = bar; b.x = xb_xcc_id(); b.st = st; b.total = total;
    if (threadIdx.x == 0) (void)xb_add(&bar[XB_XCNT(b.x)], 1u);
    return b;
}
DI void xcd_barrier_complete(unsigned* bar, unsigned x, unsigned G, unsigned& nloc, unsigned& nx) {
    unsigned sum, cnt, mine, sp = 0u;
    for (;;) {
        sum = 0u; cnt = 0u; mine = 0u;
#pragma unroll
        for (unsigned j = 0; j < 16; ++j) { const unsigned c = xb_ld(&bar[XB_XCNT(j)]); sum += c; cnt += (c > 0u) ? 1u : 0u; mine = (j == x) ? c : mine; }
        if (sum == G) break;
        __builtin_amdgcn_s_sleep(1);
        if ((++sp & 255u) == 0u) { if (xb_ld(&bar[XB_TMO])) break; if (sp > XB_SPIN_CAP) { atomicAdd(&bar[XB_TMO], 1u); break; } }
    }
    nloc = mine > 0u ? mine : 1u; nx = cnt > 0u ? cnt : 1u;
}
DI void xcd_barrier(const XcdBarrier& b) {
    asm volatile("s_waitcnt vmcnt(0)" ::: "memory");
    __syncthreads();
    if (threadIdx.x == 0) {
        unsigned* bar = b.bar;
        __builtin_amdgcn_s_waitcnt(0);
        unsigned nloc = b.st[0], nx = b.st[1];
        if (nloc == 0u) { xcd_barrier_complete(bar, b.x, b.total, nloc, nx); b.st[0] = nloc; b.st[1] = nx; }
        const unsigned old = xb_add(&bar[XB_XSUB(b.x)], 1u);
        const unsigned gen = old / nloc;
        if (old + 1u == (gen + 1u) * nloc) {
            __builtin_amdgcn_fence(__ATOMIC_RELEASE, "agent");
            asm volatile("s_waitcnt vmcnt(0)" ::: "memory");
            const unsigned og = xb_add(&bar[XB_TOP], 1u);
            const unsigned tg = og / nx;
            if (og + 1u == (tg + 1u) * nx) xb_add(&bar[XB_TOPGEN], 1u);
            else XB_SPIN(xb_ld(&bar[XB_TOPGEN]) == tg, bar);
            __builtin_amdgcn_fence(__ATOMIC_ACQUIRE, "agent");
            xb_add(&bar[XB_XGEN(b.x)], 1u);
            asm volatile("s_waitcnt vmcnt(0)" ::: "memory");
        } else {
            XB_SPIN(xb_ld(&bar[XB_XGEN(b.x)]) == gen, bar);
            __builtin_amdgcn_fence(__ATOMIC_ACQUIRE, "agent");
            asm volatile("s_waitcnt vmcnt(0)" ::: "memory");
        }
    }
    __syncthreads();
}

DI void flag_wait(unsigned* flag) {
    if (threadIdx.x == 0) {
        unsigned sp = 0;
        while (xb_ld(flag) == 0u) { __builtin_amdgcn_s_sleep(2); if (++sp > (1u << 22)) break; }
        __builtin_amdgcn_fence(__ATOMIC_ACQUIRE, "agent");
        asm volatile("s_waitcnt vmcnt(0)" ::: "memory");
    }
    __syncthreads();
}
__global__ void __launch_bounds__(512, 2) mega(Params p_, int ph_lo, int ph_hi) {
    extern __shared__ __attribute__((aligned(16))) unsigned char shm[];
    LAS unsigned char* lds = (LAS unsigned char*)shm;
    const int G = gridDim.x, GH = G >> 1;
    volatile LAS unsigned* bst = (volatile LAS unsigned*)(lds + STAGE_BYTES);
    unsigned* barw = (unsigned*)(p_.ws + OFF_BAR);
    constexpr int BSTRIDE = XCD_BAR_WORDS + 64;
    const bool single = ph_hi - ph_lo > 1;
    const int c = blockIdx.x;
    if (single) {
        if (threadIdx.x < 8) bst[threadIdx.x] = 0u;
        __syncthreads();
    }
    const int h = c & 1, ch = c >> 1;
    unsigned* flags = barw + 3 * BSTRIDE - 32;
    XcdBarrier xbar;
    if (single) xbar = xcd_barrier_post(barw + (1 + h) * BSTRIDE, bst + 4, (unsigned)GH);
    if (ph_hi < 0) cg::this_grid().sync();
    for (int ph = ph_lo; ph < ph_hi; ++ph) {
        CParams* pq = (CParams*)__builtin_amdgcn_kernarg_segment_ptr(); asm volatile("" : "+s"(pq)); CParams& p = *pq;
        if (ph == 0) { if (ONLY < 0 || ONLY == 0) phase0(p, lds, h, ch, GH); }
        else {
            const int l = (ph - 1) / 7, s = (ph - 1) % 7;
            if (single && l == 0 && ((s == 0 && h == 1) || (s == 3 && h == 0))) flag_wait(flags + (1 - h));
            if ((s == 0 || s == 2) && (ONLY < 0 || ONLY == 1)) {
                SchedZ S; S.o.init(33, s == 0 ? 15 : 11); S.G = GH; S.c = ch; S.mode = s == 0 ? 0 : 1; S.l = l; S.h = h; S.p = pq;
                EpiZ E; E.l = l; E.p = pq; E.rs = (const LAS float*)(lds + STAGE_BYTES + 32);
                rstd_table(S, (const float*)(p.ws + OFF_PART), (LAS float*)(lds + STAGE_BYTES + 32));
                gemm_phase(lds, S, E);
            } else if (s == 1 && (ONLY < 0 || ONLY == 2)) {
                phase2(p, l, lds, h, ch, GH);
            } else if (s == 3 && (ONLY < 0 || ONLY == 3)) {
                SchedPool S; S.o.init(32, 4); S.G = GH; S.c = ch; S.l = l; S.h = h; S.p = pq;
                EpiPool E; E.l = l; E.p = pq;
                gemm_phase(lds, S, E);
                mini_phase(p, l, 3, ch, GH, h, lds);
            } else if (s == 4 && (ONLY < 0 || ONLY == 4)) {
                SchedMerge S; S.o.init(32, 4); S.G = GH; S.c = ch; S.l = l; S.h = h; S.p = pq;
                EpiMerge E; E.p = pq;
                convert_p(p, l, h, ch, GH);
                gemm_phase(lds, S, E);
                mini_phase(p, l, 4, ch, GH, h, lds);
            } else if (s == 5 && (ONLY < 0 || ONLY == 5)) {
                SchedRes1 S; S.o.init(32, 4); S.G = GH; S.c = ch; S.l = l; S.h = h; S.p = pq;
                EpiRes1 E; E.l = l; E.p = pq;
                gemm_phase(lds, S, E);
                mini_phase(p, l, 5, ch, GH, h, lds);
            } else if (s == 6 && (ONLY < 0 || ONLY == 6)) {
                SchedPlain S; S.o.init(32, 4); S.G = GH; S.c = ch; S.l = l; S.h = h; S.p = pq;
                EpiRes2 E; E.l = l; E.p = pq;
                gemm_phase(lds, S, E);
                mini_phase(p, l, 6, ch, GH, h, lds);
            }
        }
        if (ph + 1 < ph_hi) {
            xcd_barrier(xbar);
            if (ph == 0 && ch == 0 && threadIdx.x == 0) {
                __builtin_amdgcn_fence(__ATOMIC_RELEASE, "agent");
                asm volatile("s_waitcnt vmcnt(0)" ::: "memory");
                __hip_atomic_store(flags + h, 1u, __ATOMIC_RELAXED, __HIP_MEMORY_SCOPE_AGENT);
            }
        }
    }
}

extern "C" void kernel_launch(void* const* d_in, const int* in_sizes, int n_in, void* d_out, int out_size, void* d_ws, size_t ws_size, hipStream_t stream) {
    (void)in_sizes; (void)n_in; (void)out_size;
    if (ws_size < WS_NEED) { fprintf(stderr, "workspace too small: %zu < %zu\n", ws_size, (size_t)WS_NEED); return; }
    Params p{};
    p.x_prompt = (const float*)d_in[0]; p.x_sample = (const float*)d_in[1]; p.cache_k = (const float*)d_in[2]; p.cache_v = (const float*)d_in[3];
    p.state_pool = (const float*)d_in[4]; p.p_prompt = (const float*)d_in[5]; p.p_sample = (const float*)d_in[6]; p.norm_g = (const float*)d_in[7];
    p.w_in = (const float*)d_in[8]; p.q_norm_g = (const float*)d_in[9]; p.k_norm_g = (const float*)d_in[10]; p.sinks = (const float*)d_in[11];
    p.pool_map = (const float*)d_in[12]; p.pool_scale = (const float*)d_in[13]; p.w_proj_pool = (const float*)d_in[14]; p.w_proj_attn = (const float*)d_in[15];
    p.w_out = (const float*)d_in[16]; p.w_ple = (const float*)d_in[17]; p.w_ple_gate = (const float*)d_in[18];
    p.out = (float*)d_out; p.ws = (unsigned char*)d_ws;
    for (int i = 0; i < 8; ++i) p.inv_freq[i] = (float)pow(500000.0, -(double)i / 8.0);
    constexpr int LDS_BYTES = STAGE_BYTES + 32 + 8192;
    static bool attr_set = false;
    if (!attr_set) { hipFuncSetAttribute((const void*)mega, hipFuncAttributeMaxDynamicSharedMemorySize, LDS_BYTES); attr_set = true; }
    constexpr int NPH = 15;
#if COOP
    static int grid_blocks = 0;
    if (!grid_blocks) {
        int dev = 0, cus = 0, per_cu = 0;
        hipGetDevice(&dev);
        hipDeviceGetAttribute(&cus, hipDeviceAttributeMultiprocessorCount, dev);
        hipOccupancyMaxActiveBlocksPerMultiprocessor(&per_cu, mega, 512, LDS_BYTES);
        if (per_cu > 1) per_cu = 1;
        grid_blocks = cus * per_cu;
    }
    int lo = 0, hi = NPH;
    (void)hipMemsetAsync((unsigned char*)d_ws + OFF_BAR, 0, 3 * (XCD_BAR_WORDS + 64) * 4, stream);
    void* args[] = {&p, &lo, &hi};
    hipError_t e = hipLaunchCooperativeKernel((const void*)mega, dim3(grid_blocks), dim3(512), args, LDS_BYTES, stream);
    if (e != hipSuccess) fprintf(stderr, "cooperative launch failed: %s (grid %d)\n", hipGetErrorString(e), grid_blocks);
#else
    for (int ph = 0; ph < NPH; ++ph) hipLaunchKernelGGL(mega, dim3(256), dim3(512), LDS_BYTES, stream, p, ph, ph + 1);
#endif
}
```

```cpp
#include <hip/hip_runtime.h>
#include <hip/hip_cooperative_groups.h>
#include <cstdio>
#include <cmath>
namespace cg = cooperative_groups;

#ifndef COOP
#define COOP 1
#endif
#ifndef ONLY
#define ONLY -1
#endif

#define LAS __attribute__((address_space(3)))
#define DI __device__ __forceinline__
typedef unsigned short bf16_t;
typedef short bf16x8 __attribute__((ext_vector_type(8)));
typedef short s16x4 __attribute__((ext_vector_type(4)));
typedef float f32x2 __attribute__((ext_vector_type(2)));
typedef float f32x4 __attribute__((ext_vector_type(4)));
typedef float f32x16 __attribute__((ext_vector_type(16)));
typedef unsigned u32x2 __attribute__((ext_vector_type(2)));
typedef unsigned u32x4 __attribute__((ext_vector_type(4)));
typedef __bf16 bf2_t __attribute__((ext_vector_type(2)));

constexpr int TP = 16384, TS = 512, TT = 16896, DM = 1024, NCOL = 6656, SEQ = 8192;
constexpr int NPM = 66;
constexpr float EPS = 1e-6f;
constexpr size_t U1 = (size_t)TT * 1024 * 2;
constexpr size_t WT_IN = 0, WT_PM = WT_IN + (size_t)NCOL * 1024 * 2, WT_PP = WT_PM + 4 * 65536 * 2, WT_PA = WT_PP + 1048576 * 2,
                 WT_WO = WT_PA + 1048576 * 2, WT_PLE = WT_WO + 1048576 * 2, WT_WG = WT_PLE + 262144 * 2, WT_LAYER = WT_WG + 1048576 * 2;
constexpr size_t OFF_WT = 0, OFF_SA = OFF_WT + 2 * WT_LAYER, OFF_SB = OFF_SA + U1, OFF_SC = OFF_SB + U1, OFF_SD = OFF_SC + U1,
                 OFF_SE = OFF_SD + U1, OFF_SF = OFF_SE + U1, OFF_PART = OFF_SF + U1, OFF_ROPE = OFF_PART + (size_t)TT * 32 * 4,
                 OFF_YAS = OFF_ROPE + (size_t)8196 * 16 * 4, OFF_BAR = OFF_YAS + (size_t)TS * 1024 * 2, WS_NEED = OFF_BAR + 3 * (3456 + 64) * 4;
constexpr size_t PANEL = (size_t)TT * 256 * 2;
constexpr size_t O_Y = 0, O_KP = 17301504, O_VP = O_KP + 131072, O_PP = O_VP + 131072, O_KS = O_PP + 61440, O_VS = O_KS + 8388608,
                 O_PS = O_VS + 8388608;

struct Params {
    const float *x_prompt, *x_sample, *cache_k, *cache_v, *state_pool, *p_prompt, *p_sample, *norm_g, *w_in, *q_norm_g, *k_norm_g, *sinks,
        *pool_map, *pool_scale, *w_proj_pool, *w_proj_attn, *w_out, *w_ple, *w_ple_gate;
    float* out;
    unsigned char* ws;
    float inv_freq[8];
};

typedef const __attribute__((address_space(4))) Params CParams;
DI unsigned pk2(float a, float b) { f32x2 v = {a, b}; bf2_t r = __builtin_convertvector(v, bf2_t); return __builtin_bit_cast(unsigned, r); }
DI float bflo(unsigned u) { return __uint_as_float(u << 16); }
DI float bfhi(unsigned u) { return __uint_as_float(u & 0xffff0000u); }
DI float bf1(bf16_t u) { return __uint_as_float(((unsigned)u) << 16); }
DI float sigmoidf_(float v) { return __builtin_amdgcn_rcpf(1.f + __expf(-v)); }
DI float siluf_(float v) { return v * sigmoidf_(v); }
DI u32x2 pk4(f32x4 v) { u32x2 r; r.x = pk2(v[0], v[1]); r.y = pk2(v[2], v[3]); return r; }
DI f32x4 unpk4(u32x2 u) { f32x4 r; r[0] = bflo(u.x); r[1] = bfhi(u.x); r[2] = bflo(u.y); r[3] = bfhi(u.y); return r; }

DI int bidx() { int b = blockIdx.x; asm volatile("" : "+s"(b)); return b; }
DI int tidx() { int t = threadIdx.x; asm volatile("" : "+v"(t)); return t; }
template <class P> DI P* launder(P* q) { asm volatile("" : "+s"(q)); return q; }
constexpr int BM = 256, BK = 64, HALF = 128, HTB = HALF * BK * 2, STAGE_BYTES = 8 * HTB, NXCD = 8, WGM = 8;
DI int lds_byte(int r, int c) { const int st = (r >> 4) * 2 + (c >> 5), rr = r & 15, cc = c & 31, ob = rr * 64 + cc * 2; return st * 1024 + (ob ^ (((ob >> 9) & 1) << 5)); }
DI void stage_rc(int b, int& R, int& C) { const int st = b / 1024, sb = b % 1024, swz = sb ^ (((sb >> 9) & 1) << 5); R = (st >> 1) * 16 + swz / 64; C = (st & 1) * 32 + (swz % 64) / 2; }

struct Unit { const char* A; const char* B; unsigned lda, ldb; int nt, pm, pn, kind, idx; };
struct TileOrder {
    int nM, nN, nwg, nx;
    DI void init(int nM_, int nN_, int nx_ = 4) { nM = nM_; nN = nN_; nwg = nM_ * nN_; nx = nx_; }
    DI void map(int L, int& pm, int& pn) const {
        unsigned wgid = (unsigned)L; { const unsigned q = (unsigned)nwg >> 2, r = (unsigned)nwg & 3u, xcd = wgid & 3u, off = wgid >> 2; wgid = (xcd < r ? xcd * (q + 1) : r * (q + 1) + (xcd - r) * q) + off; }
        const unsigned nig = (unsigned)(WGM * nN), gid = wgid / nig, fm = gid * WGM, rem = wgid - gid * nig;
        if ((unsigned)nM - fm >= (unsigned)WGM) { pm = (int)(fm + (rem & (WGM - 1))); pn = (int)(rem >> 3); }
        else { const unsigned gsz = (unsigned)nM - fm; pm = (int)(fm + rem % gsz); pn = (int)(rem / gsz); }
    }
};

typedef f32x4 Acc[2][2][4][2];

template <class Epi, class Sched>
DI void gemm_phase(LAS unsigned char* lds, const Sched& S, const Epi& E) {
    const int tid = tidx(), wid = __builtin_amdgcn_readfirstlane(tid >> 6), lane = tid & 63, wr = wid >> 2, wc = wid & 3, fr = lane & 15, fq = lane >> 4;
    int R0, C0, R1, C1; stage_rc(tid * 16, R0, C0); stage_rc(tid * 16 + 8192, R1, C1);
    const size_t kstep = (size_t)(BK * 2);
    const unsigned ldsw = (unsigned)wid * 1024u;
    const int aoff = lds_byte(wr * 64 + fr, fq * 8), boff = lds_byte(wc * 32 + fr, fq * 8);
#define G_SA(b, h) (((b) * 2 + (h)) * HTB)
#define G_SB(b, h) ((4 + (b) * 2 + (h)) * HTB)
#define G_STAGE(bufoff, gbase, v0, v1) do { \
        __builtin_amdgcn_global_load_lds((const unsigned*)((const char*)(gbase) + (v0)), (LAS unsigned*)(lds + (bufoff) + ldsw), 16, 0, 0); \
        __builtin_amdgcn_global_load_lds((const unsigned*)((const char*)(gbase) + (v1)), (LAS unsigned*)(lds + (bufoff) + ldsw + 8192), 16, 0, 0); } while (0)
#define G_LDA(dst, b, h) do { _Pragma("unroll") for (int m = 0; m < 4; ++m) _Pragma("unroll") for (int k = 0; k < 2; ++k) dst[m][k] = *(const LAS bf16x8*)(lds + G_SA(b, h) + aoff + m * 2048 + k * 1024); } while (0)
#define G_LDB(dst, b, h) do { _Pragma("unroll") for (int n = 0; n < 2; ++n) _Pragma("unroll") for (int k = 0; k < 2; ++k) dst[n][k] = *(const LAS bf16x8*)(lds + G_SB(b, h) + boff + n * 2048 + k * 1024); } while (0)
#define G_MMA(ai, bj, At, Bt) do { __builtin_amdgcn_s_setprio(1); _Pragma("unroll") for (int m = 0; m < 4; ++m) _Pragma("unroll") for (int n = 0; n < 2; ++n) _Pragma("unroll") for (int k = 0; k < 2; ++k) \
        acc[ai][bj][m][n] = __builtin_amdgcn_mfma_f32_16x16x32_bf16(Bt[n][k], At[m][k], acc[ai][bj][m][n], 0, 0, 0); __builtin_amdgcn_s_setprio(0); } while (0)
#define G_WAIT_V(n) asm volatile("s_waitcnt vmcnt(" #n ")" ::: "memory")
#define G_WAIT_L(n) asm volatile("s_waitcnt lgkmcnt(" #n ")" ::: "memory")
#define G_BAR __builtin_amdgcn_s_barrier()
#define G_SCHED __builtin_amdgcn_sched_barrier(0)
    Unit cur, nxt; int ui = 0;
    if (!S.next(0, cur)) return;
    Acc acc;
#pragma unroll
    for (int a = 0; a < 2; ++a)
#pragma unroll
        for (int b = 0; b < 2; ++b)
#pragma unroll
            for (int m = 0; m < 4; ++m)
#pragma unroll
                for (int n = 0; n < 2; ++n) acc[a][b][m][n] = (f32x4){0.f, 0.f, 0.f, 0.f};
    bf16x8 At[4][2], B0[2][2], B1[2][2];
    const char* cA = cur.A; const char* cB = cur.B;
    unsigned lda = cur.lda, ldb = cur.ldb;
    const unsigned C0b = C0 * 2, C1b = C1 * 2;
#define G_VO(R, Cb, ld) ((unsigned)(R) * (ld) + (Cb))
    unsigned vA0 = G_VO(R0, C0b, lda), vA1 = G_VO(R1, C1b, lda), vB0 = G_VO(R0, C0b, ldb), vB1 = G_VO(R1, C1b, ldb);
#define G_STA(bufoff, gbase, ld) do { if constexpr (Sched::VAR) G_STAGE(bufoff, gbase, G_VO(R0, C0b, ld), G_VO(R1, C1b, ld)); else G_STAGE(bufoff, gbase, vA0, vA1); } while (0)
#define G_STB(bufoff, gbase, ld) do { if constexpr (Sched::VAR) G_STAGE(bufoff, gbase, G_VO(R0, C0b, ld), G_VO(R1, C1b, ld)); else G_STAGE(bufoff, gbase, vB0, vB1); } while (0)
    size_t hA = (size_t)HALF * lda, hB = (size_t)HALF * ldb;
    G_STB(G_SB(0, 0), cB, ldb); G_STB(G_SB(0, 1), cB + hB, ldb); G_STA(G_SA(0, 0), cA, lda); G_STA(G_SA(0, 1), cA + hA, lda);
    if (wr == 1) G_BAR;
    G_WAIT_V(2); G_BAR;
    G_STB(G_SB(1, 0), cB + kstep, ldb); G_STA(G_SA(1, 0), cA + kstep, lda); G_STB(G_SB(1, 1), cB + hB + kstep, ldb);
    G_WAIT_V(6); G_BAR;
    for (;;) {
        const bool has_next = S.next(ui + 1, nxt);
        const char* nA = has_next ? nxt.A : cA; const char* nB = has_next ? nxt.B : cB;
        unsigned nlda = lda, nldb = ldb; size_t nhA = hA, nhB = hB;
        if constexpr (Sched::VAR) { nlda = has_next ? nxt.lda : lda; nldb = has_next ? nxt.ldb : ldb; nhA = (size_t)HALF * nlda; nhB = (size_t)HALF * nldb; }
        const int nt = cur.nt;
#pragma unroll 1
        for (int t = 0; t < nt; t += 2) {
            const bool last = (t == nt - 2);
            const char* a1 = cA + (size_t)(t + 1) * kstep;
            const char* a2 = last ? nA : cA + (size_t)(t + 2) * kstep; const char* b2 = last ? nB : cB + (size_t)(t + 2) * kstep;
            const char* a3 = a2 + kstep; const char* b3 = b2 + kstep;
            const unsigned xlda = last ? nlda : lda, xldb = last ? nldb : ldb;
            const size_t xhA = last ? nhA : hA, xhB = last ? nhB : hB;
            G_LDB(B0, 0, 0); G_LDB(B1, 0, 1); G_SCHED; G_LDA(At, 0, 0); G_STA(G_SA(1, 1), a1 + hA, lda);
            G_WAIT_V(8); G_WAIT_L(0); G_BAR; G_MMA(0, 0, At, B0); G_MMA(0, 1, At, B1); G_BAR; G_SCHED;
            G_LDA(At, 0, 1); G_STB(G_SB(0, 0), b2, xldb); G_STB(G_SB(0, 1), b2 + xhB, xldb); G_STA(G_SA(0, 0), a2, xlda);
            G_WAIT_V(8); G_WAIT_L(0); G_BAR; G_MMA(1, 0, At, B0); G_MMA(1, 1, At, B1); G_BAR; G_SCHED;
            G_LDB(B0, 1, 0); G_LDB(B1, 1, 1); G_SCHED; G_LDA(At, 1, 0); G_STA(G_SA(0, 1), a2 + xhA, xlda);
            G_WAIT_V(8); G_WAIT_L(0); G_BAR; G_MMA(0, 0, At, B0); G_MMA(0, 1, At, B1); G_BAR; G_SCHED;
            G_LDA(At, 1, 1); G_STB(G_SB(1, 0), b3, xldb); G_STB(G_SB(1, 1), b3 + xhB, xldb); G_STA(G_SA(1, 0), a3, xlda);
            G_WAIT_V(8); G_WAIT_L(0); G_BAR; G_MMA(1, 0, At, B0); G_MMA(1, 1, At, B1); G_BAR; G_SCHED;
        }
        if (wr == 0) G_BAR;
        const bool keep = E(acc, cur, wr, wc, fr, fq);
        if (!has_next) break;
        if (!keep) {
#pragma unroll
            for (int a = 0; a < 2; ++a)
#pragma unroll
                for (int b = 0; b < 2; ++b)
#pragma unroll
                    for (int m = 0; m < 4; ++m)
#pragma unroll
                        for (int n = 0; n < 2; ++n) acc[a][b][m][n] = (f32x4){0.f, 0.f, 0.f, 0.f};
        }
        cur = nxt; cA = nA; cB = nB; lda = nlda; ldb = nldb; hA = nhA; hB = nhB; ++ui;
        if (wr == 1) G_BAR;
    }
    G_WAIT_V(0);
    G_BAR;
#undef G_SA
#undef G_SB
#undef G_STAGE
#undef G_STA
#undef G_STB
#undef G_VO
#undef G_LDA
#undef G_LDB
#undef G_MMA
#undef G_WAIT_V
#undef G_WAIT_L
#undef G_BAR
#undef G_SCHED
}

DI const char* wtp(CParams* p, int l, size_t off) { return (const char*)(p->ws + OFF_WT + (size_t)l * WT_LAYER + off); }
struct SchedZ { static constexpr bool VAR = false;
    TileOrder o; int G, c, mode, l, h; CParams* p;
    DI bool next(int i, Unit& u) const {
        const int L = i * G + c; if (L >= o.nwg) return false;
        int pm, j; o.map(L, pm, j); pm = pm < 32 ? 32 * h + pm : 64 + h;
        const int ct = mode == 0 ? (j < 5 ? j : j + 3) : (j < 3 ? 5 + j : 15 + j);
        u.A = (l == 0 ? (const char*)(p->ws + OFF_SA) : (const char*)p->out) + (size_t)pm * 256 * 2048; u.B = wtp(p, l, WT_IN) + (size_t)ct * 256 * 2048; u.lda = 2048; u.ldb = 2048; u.nt = 16; u.pm = pm; u.pn = ct; u.kind = 0; u.idx = i; return true;
    }
};
struct SchedPool { static constexpr bool VAR = false;
    TileOrder o; int G, c, l, h; CParams* p;
    DI bool next(int i, Unit& u) const {
        const int L = i * G + c; if (L >= o.nwg) return false;
        int pm, g; o.map(L, pm, g); pm += 32 * h;
        u.A = (const char*)(p->ws + OFF_SF) + (size_t)pm * 256 * 2048 + g * 512; u.B = wtp(p, l, WT_PM) + (size_t)g * 256 * 512; u.lda = 2048; u.ldb = 512; u.nt = 4; u.pm = pm; u.pn = g; u.kind = 0; return true;
    }
};
struct SchedMerge { static constexpr bool VAR = false;
    TileOrder o; int G, c, l, h; CParams* p;
    DI bool next(int i, Unit& u) const {
        const int L = (i >> 1) * G + c; if (L >= o.nwg) return false;
        int pm, pn; o.map(L, pm, pn); pm += 32 * h; const int seg = i & 1;
        u.A = (const char*)(p->ws + (seg ? OFF_SC : OFF_SF)) + (size_t)pm * 256 * 2048; u.B = wtp(p, l, seg ? WT_PA : WT_PP) + (size_t)pn * 256 * 2048; u.lda = 2048; u.ldb = 2048; u.nt = 16; u.pm = pm; u.pn = pn; u.kind = seg; return true;
    }
};
struct SchedRes1 { static constexpr bool VAR = true;
    TileOrder o; int G, c, l, h; CParams* p;
    DI bool next(int i, Unit& u) const {
        int L = i * G + c; if (L >= 2 * o.nwg) return false;
        const int kind = L >= o.nwg; if (kind) L -= o.nwg;
        int pm, pn; o.map(L, pm, pn); pm += 32 * h;
        if (!kind) { u.A = (const char*)(p->ws + OFF_SA) + (size_t)pm * 256 * 2048; u.B = wtp(p, l, WT_WO) + (size_t)pn * 256 * 2048; u.lda = 2048; u.ldb = 2048; u.nt = 16; }
        else { u.A = (const char*)(p->ws + OFF_SE) + (size_t)pm * 256 * 512; u.B = wtp(p, l, WT_PLE) + (size_t)pn * 256 * 512; u.lda = 512; u.ldb = 512; u.nt = 4; }
        u.pm = pm; u.pn = pn; u.kind = kind; return true;
    }
};
struct SchedPlain { static constexpr bool VAR = false;
    TileOrder o; int G, c, l, h; CParams* p;
    DI bool next(int i, Unit& u) const {
        const int L = i * G + c; if (L >= o.nwg) return false;
        int pm, pn; o.map(L, pm, pn); pm += 32 * h;
        u.A = (const char*)(p->ws + OFF_SC) + (size_t)pm * 256 * 2048; u.B = wtp(p, l, WT_WG) + (size_t)pn * 256 * 2048; u.lda = 2048; u.ldb = 2048; u.nt = 16; u.pm = pm; u.pn = pn; u.kind = 0; return true;
    }
};

DI float rstd_row(const float* part, int row) {
    const f32x4* q = (const f32x4*)(part + (size_t)row * 32);
    f32x4 t = q[0];
#pragma unroll
    for (int i = 1; i < 8; ++i) t += q[i];
    const float s = (t[0] + t[1]) + (t[2] + t[3]);
    return __builtin_amdgcn_rsqf(s * (1.f / 1024.f) + EPS);
}
DI u32x4 pk8(f32x4 a, f32x4 b) { u32x4 r; r[0] = pk2(a[0], a[1]); r[1] = pk2(a[2], a[3]); r[2] = pk2(b[0], b[1]); r[3] = pk2(b[2], b[3]); return r; }
DI void unpk8(u32x4 u, f32x4& a, f32x4& b) { a[0] = bflo(u[0]); a[1] = bfhi(u[0]); a[2] = bflo(u[1]); a[3] = bfhi(u[1]); b[0] = bflo(u[2]); b[1] = bfhi(u[2]); b[2] = bflo(u[3]); b[3] = bfhi(u[3]); }

template <class Sched>
DI void rstd_table(const Sched& S, const float* part, LAS float* rs) {
    const int tid = tidx();
    Unit u;
    for (int i = 0; i < 8 && S.next(i, u); ++i)
        if (tid < 256) rs[i * 256 + tid] = rstd_row(part, u.pm * 256 + tid);
    __syncthreads();
}
struct EpiZ {
    int l; CParams* p; const LAS float* rs;
    DI bool operator()(Acc& acc, const Unit& u, int wr, int wc, int fr, int fq) const {
        unsigned char* ws = p->ws; float* out = p->out;
        const int ct = u.pn, row0 = u.pm * 256 + wr * 64 + fr, cl0 = wc * 64 + 16 * fq;
        if (ct < 4) {
            const bool special = (u.pm == 31) | (u.pm >= 63);
#pragma unroll
            for (int ai = 0; ai < 2; ++ai)
#pragma unroll
                for (int m = 0; m < 4; ++m) {
                    const int row = row0 + ai * 128 + m * 16; const float rsv = rs[(u.idx & 7) * 256 + (row & 255)];
                    float* po = nullptr;
                    if (special) {
                        if (row >= TP) { const int sb = (row - TP) >> 2, i = row & 3; po = out + O_PS + ((size_t)(l * 128 + sb) * 15 + 11 + i) * 1024; }
                        else { const int t = row & (SEQ - 1), b = row >> 13; if (t >= SEQ - 15) po = out + O_PP + ((size_t)(l * 2 + b) * 15 + (t - (SEQ - 15))) * 1024; }
                    }
#pragma unroll
                    for (int bj = 0; bj < 2; ++bj) {
                        const int col = ct * 256 + cl0 + 8 * bj;
                        const f32x4 v0 = acc[ai][bj][m][0] * rsv, v1 = acc[ai][bj][m][1] * rsv;
                        *(u32x4*)((bf16_t*)(ws + OFF_SB) + (size_t)row * 1024 + col) = pk8(v0, v1);
                        if (po) { *(f32x4*)(po + col) = v0; *(f32x4*)(po + col + 4) = v1; }
                    }
                }
        } else if (ct >= 18) {
            bf16_t* RB = (bf16_t*)(ws + OFF_SB); bf16_t* GB = (bf16_t*)(ws + OFF_SD);
#pragma unroll
            for (int ai = 0; ai < 2; ++ai)
#pragma unroll
                for (int m = 0; m < 4; ++m) {
                    __builtin_amdgcn_sched_barrier(0);
                    const int row = row0 + ai * 128 + m * 16; const float rsv = rs[(u.idx & 7) * 256 + (row & 255)];
                    const size_t off = (size_t)row * 1024 + (ct - 18) * 128 + wc * 32 + 8 * fq;
                    f32x4 r[2], g[2];
#pragma unroll
                    for (int n = 0; n < 2; ++n) {
                        const f32x4 xa = acc[ai][0][m][n] * rsv, xb = acc[ai][1][m][n] * rsv;
#pragma unroll
                        for (int j = 0; j < 4; ++j) { const float ea = 1.f + __expf(-xa[j]), eb = 1.f + __expf(-xb[j]); r[n][j] = eb * __builtin_amdgcn_rcpf(ea); g[n][j] = __builtin_amdgcn_rcpf(eb); }
                    }
                    *(u32x4*)(RB + off) = pk8(r[0], r[1]);
                    *(u32x4*)(GB + off) = pk8(g[0], g[1]);
                }
        } else if (ct < 8 || (ct >= 14)) {
            bf16_t* dst; int ld, cbase; bool silu;
            if (ct < 8) { dst = (bf16_t*)(ws + OFF_SE) + (size_t)(ct - 4) * ((size_t)TT * 256); ld = 256; cbase = 0; silu = true; }
            else { dst = (bf16_t*)(ws + OFF_SD); ld = 1024; cbase = (ct - 14) * 256; silu = true; }
#pragma unroll
            for (int ai = 0; ai < 2; ++ai)
#pragma unroll
                for (int m = 0; m < 4; ++m) {
                    const int row = row0 + ai * 128 + m * 16; const float rsv = rs[(u.idx & 7) * 256 + (row & 255)];
#pragma unroll
                    for (int bj = 0; bj < 2; ++bj) {
                        const int col = cbase + cl0 + 8 * bj;
                        f32x4 v0 = acc[ai][bj][m][0] * rsv, v1 = acc[ai][bj][m][1] * rsv;
#pragma unroll
                        for (int j = 0; j < 4; ++j) { const float s0 = sigmoidf_(v0[j]), s1 = sigmoidf_(v1[j]); v0[j] = silu ? v0[j] * s0 : s0; v1[j] = silu ? v1[j] * s1 : s1; }
                        *(u32x4*)(dst + (size_t)row * ld + col) = pk8(v0, v1);
                    }
                }
        } else if (ct < 13) {
            const bool isk = ct == 12;
            const float* gw = (isk ? p->k_norm_g : p->q_norm_g) + l * 64; const float* rope = (const float*)(ws + OFF_ROPE);
            f32x4 gv[2][2];
#pragma unroll
            for (int bj = 0; bj < 2; ++bj)
#pragma unroll
                for (int n = 0; n < 2; ++n) gv[bj][n] = *(const f32x4*)(gw + 16 * fq + 8 * bj + 4 * n);
            const float osc = isk ? 1.f : 0.125f;
            const int head = isk ? wc : (ct - 8) * 4 + wc;
#pragma unroll
            for (int ai = 0; ai < 2; ++ai)
#pragma unroll
                for (int m = 0; m < 4; ++m) {
                    const int row = row0 + ai * 128 + m * 16; const float rsv = rs[(u.idx & 7) * 256 + (row & 255)];
                    f32x4 v[2][2]; float ss = 0.f;
#pragma unroll
                    for (int bj = 0; bj < 2; ++bj)
#pragma unroll
                        for (int n = 0; n < 2; ++n) { v[bj][n] = acc[ai][bj][m][n] * rsv;
#pragma unroll
                            for (int j = 0; j < 4; ++j) ss += v[bj][n][j] * v[bj][n][j]; }
                    ss += __shfl_xor(ss, 16); ss += __shfl_xor(ss, 32);
                    const float rn = __builtin_amdgcn_rsqf(ss * (1.f / 64.f) + EPS);
#pragma unroll
                    for (int bj = 0; bj < 2; ++bj)
#pragma unroll
                        for (int n = 0; n < 2; ++n) v[bj][n] = v[bj][n] * rn * gv[bj][n];
                    if (fq == 0) {
                        const int pidx = row < TP ? (row & (SEQ - 1)) : SEQ + (row & 3);
                        const f32x4* rp = (const f32x4*)(rope + (size_t)pidx * 16);
                        const f32x4 c0 = rp[0], c1 = rp[1], s0 = rp[2], s1 = rp[3];
                        const f32x4 a0 = v[0][0], a1 = v[0][1], b0 = v[1][0], b1 = v[1][1];
                        v[0][0] = a0 * c0 - b0 * s0; v[0][1] = a1 * c1 - b1 * s1;
                        v[1][0] = b0 * c0 + a0 * s0; v[1][1] = b1 * c1 + a1 * s1;
                    }
                    float* po = nullptr;
                    if (isk) {
                        if (row >= TP) { const int sb = (row - TP) >> 2, i = row & 3; po = out + O_KS + (((size_t)(l * 128 + sb) * 128 + 124 + i) * 4 + wc) * 64; }
                        else { const int t = row & (SEQ - 1), b = row >> 13; if (t >= SEQ - 128) po = out + O_KP + (((size_t)(l * 2 + b) * 128 + (t - (SEQ - 128))) * 4 + wc) * 64; }
                    }
                    bf16_t* dst = isk ? (bf16_t*)(ws + OFF_SE + 2 * PANEL) + (size_t)row * 256 + wc * 64 : (bf16_t*)(ws + OFF_SC) + (size_t)row * 1024 + head * 64;
#pragma unroll
                    for (int bj = 0; bj < 2; ++bj) {
                        const int d = 16 * fq + 8 * bj;
                        if (po) { *(f32x4*)(po + d) = v[bj][0]; *(f32x4*)(po + d + 4) = v[bj][1]; }
                        *(u32x4*)(dst + d) = pk8(v[bj][0] * osc, v[bj][1] * osc);
                    }
                }
        } else {
#pragma unroll
            for (int ai = 0; ai < 2; ++ai)
#pragma unroll
                for (int m = 0; m < 4; ++m) {
                    const int row = row0 + ai * 128 + m * 16; const float rsv = rs[(u.idx & 7) * 256 + (row & 255)];
                    float* po = nullptr;
                    if (row >= TP) { const int sb = (row - TP) >> 2, i = row & 3; po = out + O_VS + ((size_t)(l * 128 + sb) * 128 + 124 + i) * 256; }
                    else { const int t = row & (SEQ - 1), b = row >> 13; if (t >= SEQ - 128) po = out + O_VP + ((size_t)(l * 2 + b) * 128 + (t - (SEQ - 128))) * 256; }
#pragma unroll
                    for (int bj = 0; bj < 2; ++bj) {
                        const int col = cl0 + 8 * bj;
                        const f32x4 v0 = acc[ai][bj][m][0] * rsv, v1 = acc[ai][bj][m][1] * rsv;
                        if (po) { *(f32x4*)(po + col) = v0; *(f32x4*)(po + col + 4) = v1; }
                        *(u32x4*)((bf16_t*)(ws + OFF_SE + 3 * PANEL) + (size_t)row * 256 + col) = pk8(v0, v1);
                    }
                }
        }
        return false;
    }
};

struct EpiPool {
    int l; CParams* p;
    DI bool operator()(Acc& acc, const Unit& u, int wr, int wc, int fr, int fq) const {
        const float* scale = p->pool_scale + l * 1024; const bf16_t* SZP = (const bf16_t*)(p->ws + OFF_SE); bf16_t* YA = (bf16_t*)(p->ws + OFF_SF);
        const int g = u.pn, row0 = u.pm * 256 + wr * 64 + fr, cl0 = wc * 64 + 16 * fq;
        const bf16_t* zp = SZP + (size_t)g * ((size_t)TT * 256);
        f32x4 sc[2][2];
#pragma unroll
        for (int bj = 0; bj < 2; ++bj)
#pragma unroll
            for (int n = 0; n < 2; ++n) sc[bj][n] = *(const f32x4*)(scale + g * 256 + cl0 + 8 * bj + 4 * n);
#pragma unroll
        for (int ai = 0; ai < 2; ++ai)
#pragma unroll
            for (int m = 0; m < 4; ++m) {
                const int row = row0 + ai * 128 + m * 16;
#pragma unroll
                for (int bj = 0; bj < 2; ++bj) {
                    const int cl = cl0 + 8 * bj;
                    f32x4 z0, z1; unpk8(*(const u32x4*)(zp + (size_t)row * 256 + cl), z0, z1);
                    *(u32x4*)(YA + (size_t)row * 1024 + g * 256 + cl) = pk8(acc[ai][bj][m][0] * sc[bj][0] * z0, acc[ai][bj][m][1] * sc[bj][1] * z1);
                }
            }
        return false;
    }
};

struct EpiMerge {
    CParams* p;
    DI bool operator()(Acc& acc, const Unit& u, int wr, int wc, int fr, int fq) const {
        const int row0 = u.pm * 256 + wr * 64 + fr, c0 = u.pn * 256 + wc * 64 + 16 * fq;
        const bf16_t* G = (const bf16_t*)(p->ws + (u.kind == 0 ? OFF_SB : OFF_SD)) + (size_t)row0 * 1024 + c0; bf16_t* M = (bf16_t*)(p->ws + OFF_SA) + (size_t)row0 * 1024 + c0;
        u32x4 buf[2][4];
#pragma unroll
        for (int st = 0; st <= 4; ++st) {
            if (st < 4) {
#pragma unroll
                for (int mm = 0; mm < 2; ++mm)
#pragma unroll
                    for (int bj = 0; bj < 2; ++bj) buf[st & 1][mm * 2 + bj] = *(const u32x4*)(G + (size_t)((st >> 1) * 128 + ((st & 1) * 2 + mm) * 16) * 1024 + 8 * bj);
            }
            __builtin_amdgcn_sched_barrier(0);
            if (st > 0) {
                const int q = st - 1, ai = q >> 1;
#pragma unroll
                for (int mm = 0; mm < 2; ++mm)
#pragma unroll
                    for (int bj = 0; bj < 2; ++bj) {
                        const int m = (q & 1) * 2 + mm;
                        f32x4 g0, g1; unpk8(buf[q & 1][mm * 2 + bj], g0, g1);
                        if (u.kind == 0) { acc[ai][bj][m][0] *= g0; acc[ai][bj][m][1] *= g1; }
                        else *(u32x4*)(M + (size_t)(ai * 128 + m * 16) * 1024 + 8 * bj) = pk8(acc[ai][bj][m][0] * g0, acc[ai][bj][m][1] * g1);
                    }
                __builtin_amdgcn_sched_barrier(0);
            }
        }
        return u.kind == 0;
    }
};

struct EpiRes1 {
    int l; CParams* p;
    DI bool operator()(Acc& acc, const Unit& u, int wr, int wc, int fr, int fq) const {
        const int row0 = u.pm * 256 + wr * 64 + fr, c0 = u.pn * 256 + wc * 64 + 16 * fq;
        if (u.kind != 0) {
            bf16_t* E = (bf16_t*)(p->ws + OFF_SB) + (size_t)row0 * 1024 + c0;
#pragma unroll
            for (int ai = 0; ai < 2; ++ai)
#pragma unroll
                for (int m = 0; m < 4; ++m)
#pragma unroll
                    for (int bj = 0; bj < 2; ++bj) *(u32x4*)(E + (size_t)(ai * 128 + m * 16) * 1024 + 8 * bj) = pk8(acc[ai][bj][m][0], acc[ai][bj][m][1]);
            return false;
        }
        bf16_t* H1B = (bf16_t*)(p->ws + OFF_SC) + (size_t)row0 * 1024 + c0;
        if (l == 0) {
            const float* hin = (row0 < TP ? p->x_prompt + (size_t)row0 * 1024 : p->x_sample + (size_t)(row0 - TP) * 1024) + c0;
            f32x4 buf[2][8];
#pragma unroll
            for (int st = 0; st <= 4; ++st) {
                if (st < 4) {
#pragma unroll
                    for (int mm = 0; mm < 2; ++mm)
#pragma unroll
                        for (int bj = 0; bj < 2; ++bj) { const float* q = hin + (size_t)((st >> 1) * 128 + ((st & 1) * 2 + mm) * 16) * 1024 + 8 * bj; buf[st & 1][(mm * 2 + bj) * 2] = *(const f32x4*)q; buf[st & 1][(mm * 2 + bj) * 2 + 1] = *(const f32x4*)(q + 4); }
                }
                __builtin_amdgcn_sched_barrier(0);
                if (st > 0) {
                    const int q = st - 1, ai = q >> 1;
#pragma unroll
                    for (int mm = 0; mm < 2; ++mm)
#pragma unroll
                        for (int bj = 0; bj < 2; ++bj) { const int m = (q & 1) * 2 + mm;
                            *(u32x4*)(H1B + (size_t)(ai * 128 + m * 16) * 1024 + 8 * bj) = pk8(buf[q & 1][(mm * 2 + bj) * 2] + acc[ai][bj][m][0], buf[q & 1][(mm * 2 + bj) * 2 + 1] + acc[ai][bj][m][1]); }
                    __builtin_amdgcn_sched_barrier(0);
                }
            }
        } else {
            const bf16_t* HB = (const bf16_t*)p->out + (size_t)row0 * 1024 + c0;
            u32x4 buf[2][4];
#pragma unroll
            for (int st = 0; st <= 4; ++st) {
                if (st < 4) {
#pragma unroll
                    for (int mm = 0; mm < 2; ++mm)
#pragma unroll
                        for (int bj = 0; bj < 2; ++bj) buf[st & 1][mm * 2 + bj] = *(const u32x4*)(HB + (size_t)((st >> 1) * 128 + ((st & 1) * 2 + mm) * 16) * 1024 + 8 * bj);
                }
                __builtin_amdgcn_sched_barrier(0);
                if (st > 0) {
                    const int q = st - 1, ai = q >> 1;
#pragma unroll
                    for (int mm = 0; mm < 2; ++mm)
#pragma unroll
                        for (int bj = 0; bj < 2; ++bj) { const int m = (q & 1) * 2 + mm; f32x4 h0, h1; unpk8(buf[q & 1][mm * 2 + bj], h0, h1);
                            *(u32x4*)(H1B + (size_t)(ai * 128 + m * 16) * 1024 + 8 * bj) = pk8(h0 + acc[ai][bj][m][0], h1 + acc[ai][bj][m][1]); }
                    __builtin_amdgcn_sched_barrier(0);
                }
            }
        }
        return false;
    }
};

struct EpiRes2 {
    int l; CParams* p;
    DI bool operator()(Acc& acc, const Unit& u, int wr, int wc, int fr, int fq) const {
        const int row0 = u.pm * 256 + wr * 64 + fr, c0 = u.pn * 256 + wc * 64 + 16 * fq;
        const size_t o0_ = (size_t)row0 * 1024 + c0;
        float* y = p->out + O_Y + o0_; bf16_t* HB = (bf16_t*)p->out + o0_; const bf16_t* H1B = (const bf16_t*)(p->ws + OFF_SC) + o0_; const bf16_t* E = (const bf16_t*)(p->ws + OFF_SB) + o0_;
        float* part = (float*)(p->ws + OFF_PART) + (size_t)row0 * 32 + u.pn * 8 + wc * 2;
        u32x4 bh[2][4], be[2][4];
#pragma unroll
        for (int st = 0; st <= 4; ++st) {
            if (st < 4) {
#pragma unroll
                for (int mm = 0; mm < 2; ++mm)
#pragma unroll
                    for (int bj = 0; bj < 2; ++bj) { const size_t o = (size_t)((st >> 1) * 128 + ((st & 1) * 2 + mm) * 16) * 1024 + 8 * bj; bh[st & 1][mm * 2 + bj] = *(const u32x4*)(H1B + o); be[st & 1][mm * 2 + bj] = *(const u32x4*)(E + o); }
            }
            __builtin_amdgcn_sched_barrier(0);
            if (st > 0) {
                const int q = st - 1, ai = q >> 1;
#pragma unroll
                for (int mm = 0; mm < 2; ++mm) {
                    const int m = (q & 1) * 2 + mm;
                    float ssb[2];
#pragma unroll
                    for (int bj = 0; bj < 2; ++bj) {
                        float ss = 0.f;
                        const size_t o = (size_t)(ai * 128 + m * 16) * 1024 + 8 * bj;
                        f32x4 h0, h1, e0, e1; unpk8(bh[q & 1][mm * 2 + bj], h0, h1); unpk8(be[q & 1][mm * 2 + bj], e0, e1);
                        f32x4 o0, o1;
#pragma unroll
                        for (int j = 0; j < 4; ++j) { o0[j] = h0[j] + sigmoidf_(acc[ai][bj][m][0][j]) * e0[j]; o1[j] = h1[j] + sigmoidf_(acc[ai][bj][m][1][j]) * e1[j]; ss += o0[j] * o0[j] + o1[j] * o1[j]; }
                        if (l == 0) *(u32x4*)(HB + o) = pk8(o0, o1);
                        else { *(f32x4*)(y + o) = o0; *(f32x4*)(y + o + 4) = o1; }
                        ss += __shfl_xor(ss, 16); ss += __shfl_xor(ss, 32);
                        ssb[bj] = ss;
                    }
                    if (fq == 0) *(f32x2*)(part + (size_t)(ai * 128 + m * 16) * 32) = (f32x2){ssb[0], ssb[1]};
                }
                __builtin_amdgcn_sched_barrier(0);
            }
        }
        return false;
    }
};

struct MiniTile { int row0, pn, bj, wc; };
DI MiniTile mini_tile(int mt, int h) { MiniTile t; t.row0 = TP + 256 * h + 64 * (mt & 3); const int cg = mt >> 2; t.pn = cg >> 3; t.bj = (cg >> 2) & 1; t.wc = cg & 3; return t; }
template <int KSTEPS  >
DI void mini_partial(LAS float* red, const bf16_t* A, int lda, const bf16_t* Bt, int ldb, int tid) {
    const int wid = tid >> 6, lane = tid & 63, fr = lane & 15, fq = lane >> 4;
    const int k0 = wid * (32 * KSTEPS) + 8 * fq;
    bf16x8 af[KSTEPS][4], bfr[KSTEPS][2];
#pragma unroll
    for (int s = 0; s < KSTEPS; ++s) {
#pragma unroll
        for (int m = 0; m < 4; ++m) af[s][m] = *(const bf16x8*)(A + (size_t)(16 * m + fr) * lda + k0 + 32 * s);
#pragma unroll
        for (int n = 0; n < 2; ++n) bfr[s][n] = *(const bf16x8*)(Bt + (size_t)(16 * n + fr) * ldb + k0 + 32 * s);
    }
    f32x4 acc[4][2];
#pragma unroll
    for (int m = 0; m < 4; ++m)
#pragma unroll
        for (int n = 0; n < 2; ++n) acc[m][n] = (f32x4){0.f, 0.f, 0.f, 0.f};
#pragma unroll
    for (int s = 0; s < KSTEPS; ++s)
#pragma unroll
        for (int m = 0; m < 4; ++m)
#pragma unroll
            for (int n = 0; n < 2; ++n) acc[m][n] = __builtin_amdgcn_mfma_f32_16x16x32_bf16(bfr[s][n], af[s][m], acc[m][n], 0, 0, 0);
    LAS float* mine = red + wid * 2048;
#pragma unroll
    for (int m = 0; m < 4; ++m)
#pragma unroll
        for (int n = 0; n < 2; ++n) *(LAS f32x4*)(mine + (16 * m + fr) * 32 + 16 * n + 4 * fq) = acc[m][n];
}
DI f32x4 mini_sum(const LAS float* red, int tid) {
    f32x4 s = *(const LAS f32x4*)(red + tid * 4);
#pragma unroll
    for (int w = 1; w < 8; ++w) s += *(const LAS f32x4*)(red + w * 2048 + tid * 4);
    return s;
}
DI void mini_phase(CParams& p, int l, int kind, int c, int G, int h, LAS unsigned char* lds) {
    LAS float* red0 = (LAS float*)lds; LAS float* red1 = red0 + 16384;
    unsigned char* ws = p.ws;
    const unsigned char* wt = ws + OFF_WT + (size_t)l * WT_LAYER;
    for (int mt = c; mt < 128; mt += G) {
        const int tid = tidx();
        const MiniTile t = mini_tile(mt, h);
        const int srow = 128 * t.bj + 32 * t.wc;
        const int row = t.row0 + (tid >> 3), sq = tid & 7;
        const int col = t.pn * 256 + 64 * t.wc + 16 * (sq & 3) + 8 * t.bj + 4 * (sq >> 2);
        __syncthreads();
        if (kind == 3) {
            const bf16_t* A = (const bf16_t*)(ws + OFF_SF) + (size_t)t.row0 * 1024 + t.pn * 256;
            const bf16_t* B = (const bf16_t*)(wt + WT_PM) + (size_t)(t.pn * 256 + srow) * 256;
            mini_partial<1>(red0, A, 1024, B, 256, tid);
            __syncthreads();
            const f32x4 v = mini_sum(red0, tid);
            const f32x4 sc = *(const f32x4*)(p.pool_scale + l * 1024 + col);
            const f32x4 z = unpk4(*(const u32x2*)((const bf16_t*)(ws + OFF_SE) + (size_t)t.pn * ((size_t)TT * 256) + (size_t)row * 256 + (col & 255)));
            *(u32x2*)((bf16_t*)(ws + OFF_YAS) + (size_t)(row - TP) * 1024 + col) = pk4(v * sc * z);
        } else if (kind == 4) {
            mini_partial<4>(red0, (const bf16_t*)(ws + OFF_YAS) + (size_t)(t.row0 - TP) * 1024, 1024, (const bf16_t*)(wt + WT_PP) + (size_t)(t.pn * 256 + srow) * 1024, 1024, tid);
            mini_partial<4>(red1, (const bf16_t*)(ws + OFF_SC) + (size_t)t.row0 * 1024, 1024, (const bf16_t*)(wt + WT_PA) + (size_t)(t.pn * 256 + srow) * 1024, 1024, tid);
            __syncthreads();
            const f32x4 a = mini_sum(red0, tid), b = mini_sum(red1, tid);
            const size_t off = (size_t)row * 1024 + col;
            const f32x4 ga = unpk4(*(const u32x2*)((const bf16_t*)(ws + OFF_SB) + off)), gb = unpk4(*(const u32x2*)((const bf16_t*)(ws + OFF_SD) + off));
            *(u32x2*)((bf16_t*)(ws + OFF_SA) + off) = pk4(gb * (ga * a + b));
        } else if (kind == 5) {
            mini_partial<4>(red0, (const bf16_t*)(ws + OFF_SA) + (size_t)t.row0 * 1024, 1024, (const bf16_t*)(wt + WT_WO) + (size_t)(t.pn * 256 + srow) * 1024, 1024, tid);
            mini_partial<1>(red1, (const bf16_t*)(ws + OFF_SE) + (size_t)t.row0 * 256, 256, (const bf16_t*)(wt + WT_PLE) + (size_t)(t.pn * 256 + srow) * 256, 256, tid);
            __syncthreads();
            const f32x4 a = mini_sum(red0, tid), e = mini_sum(red1, tid);
            const size_t off = (size_t)row * 1024 + col;
            const f32x4 hin = l == 0 ? *(const f32x4*)(p.x_sample + (size_t)(row - TP) * 1024 + col) : unpk4(*(const u32x2*)((const bf16_t*)p.out + off));
            const f32x4 h1 = hin + a;
            *(u32x2*)((bf16_t*)(ws + OFF_SC) + off) = pk4(h1);
            *(u32x2*)((bf16_t*)(ws + OFF_SB) + off) = pk4(e);
        } else {
            mini_partial<4>(red0, (const bf16_t*)(ws + OFF_SC) + (size_t)t.row0 * 1024, 1024, (const bf16_t*)(wt + WT_WG) + (size_t)(t.pn * 256 + srow) * 1024, 1024, tid);
            __syncthreads();
            const f32x4 a = mini_sum(red0, tid);
            const size_t off = (size_t)row * 1024 + col;
            const f32x4 h1 = unpk4(*(const u32x2*)((const bf16_t*)(ws + OFF_SC) + off));
            const f32x4 e = unpk4(*(const u32x2*)((const bf16_t*)(ws + OFF_SB) + off));
            f32x4 h2; float ss = 0.f;
#pragma unroll
            for (int j = 0; j < 4; ++j) { h2[j] = h1[j] + sigmoidf_(a[j]) * e[j]; ss += h2[j] * h2[j]; }
            if (l == 0) *(u32x2*)((bf16_t*)p.out + off) = pk4(h2);
            else *(f32x4*)(p.out + O_Y + off) = h2;
            ss += __shfl_xor(ss, 1); ss += __shfl_xor(ss, 2); ss += __shfl_xor(ss, 4);
            if (sq == 0) ((float*)(ws + OFF_PART))[(size_t)row * 32 + t.pn * 8 + t.wc * 2 + t.bj] = ss;
        }
    }
}

struct WtDesc { const float* src; const float* gscale; bf16_t* dst; int ld_src, ld_dst, k0, c0; };
DI WtDesc wt_desc(CParams& p, int it) {
    WtDesc d; const int l = it / 2816; int r = it % 2816;
    unsigned char* wt = p.ws + OFF_WT + (size_t)l * WT_LAYER;
    d.gscale = nullptr;
    if (r < 1664) { const int kt = r / 104, ctile = r % 104;
        d.src = p.w_in + (size_t)l * 1024 * NCOL; d.ld_src = NCOL; d.k0 = kt * 64; d.c0 = ctile * 64; d.dst = (bf16_t*)(wt + WT_IN); d.ld_dst = 1024; d.gscale = p.norm_g + l * 1024;
    } else if ((r -= 1664) < 64) { const int g = r >> 4, kt = (r >> 2) & 3, ctile = r & 3;
        d.src = p.pool_map + (size_t)(l * 4 + g) * 65536; d.ld_src = 256; d.k0 = kt * 64; d.c0 = ctile * 64; d.dst = (bf16_t*)(wt + WT_PM) + (size_t)g * 65536; d.ld_dst = 256;
    } else if ((r -= 64) < 1024) { const int w = r >> 8, kt = (r >> 4) & 15, ctile = r & 15;
        d.src = (w == 0 ? p.w_proj_pool : w == 1 ? p.w_proj_attn : w == 2 ? p.w_out : p.w_ple_gate) + (size_t)l * 1048576;
        d.dst = (bf16_t*)(wt + (w == 0 ? WT_PP : w == 1 ? WT_PA : w == 2 ? WT_WO : WT_WG)); d.ld_src = 1024; d.ld_dst = 1024; d.k0 = kt * 64; d.c0 = ctile * 64;
    } else { r -= 1024; const int kt = r >> 4, ctile = r & 15;
        d.src = p.w_ple + (size_t)l * 262144; d.ld_src = 1024; d.k0 = kt * 64; d.c0 = ctile * 64; d.dst = (bf16_t*)(wt + WT_PLE); d.ld_dst = 256;
    }
    return d;
}
DI void wt_load(const WtDesc& d, int tid, f32x4& v0, f32x4& v1) {
    const int kk = tid >> 4, c4 = (tid & 15) * 4;
    v0 = __builtin_nontemporal_load((const f32x4*)(d.src + (size_t)(d.k0 + kk) * d.ld_src + d.c0 + c4));
    v1 = __builtin_nontemporal_load((const f32x4*)(d.src + (size_t)(d.k0 + kk + 32) * d.ld_src + d.c0 + c4));
    if (d.gscale) { v0 *= d.gscale[d.k0 + kk]; v1 *= d.gscale[d.k0 + kk + 32]; }
}

DI void phase0(CParams& p, LAS unsigned char* lds, int h, int bid, int G) {
    const int tid = tidx();
    LAS float* tile = (LAS float*)lds;
    {
        const int it_end = h == 0 ? 1664 : 2 * 2816;
        int it = (h == 0 ? 0 : 1664) + bid;
        WtDesc d = wt_desc(p, it < it_end ? it : 0);
        f32x4 v0, v1; wt_load(d, tid, v0, v1);
        for (; it < it_end; it += G) {
            const int nit = it + G < it_end ? it + G : it;
            const WtDesc dn = wt_desc(p, nit);
            f32x4 n0, n1; wt_load(dn, tid, n0, n1);
            __syncthreads();
            { const int kk = tid >> 4, c4 = (tid & 15) * 4;
#pragma unroll
              for (int j = 0; j < 4; ++j) { tile[(c4 + j) * 65 + kk] = v0[j]; tile[(c4 + j) * 65 + kk + 32] = v1[j]; } }
            __syncthreads();
            { const int cc = tid >> 3, ks = (tid & 7) * 8;
              int c = d.c0 + cc;
              if (d.gscale && c >= 4608) {
                  const int gcol = (c - 4608) & 1023, isb = (c - 4608) >> 10, lc = gcol & 127;
                  c = (18 + (gcol >> 7)) * 256 + 128 * isb + 32 * (lc >> 5) + 16 * ((lc >> 2) & 1) + 4 * ((lc >> 3) & 3) + (lc & 3);
              } else { const int a = c & 255; c = (c & ~255) + (128 * ((a >> 3) & 1) + 32 * (a >> 6) + 16 * ((a >> 2) & 1) + 4 * ((a >> 4) & 3) + (a & 3)); }
              u32x4 o;
              o[0] = pk2(tile[cc * 65 + ks + 0], tile[cc * 65 + ks + 1]); o[1] = pk2(tile[cc * 65 + ks + 2], tile[cc * 65 + ks + 3]);
              o[2] = pk2(tile[cc * 65 + ks + 4], tile[cc * 65 + ks + 5]); o[3] = pk2(tile[cc * 65 + ks + 6], tile[cc * 65 + ks + 7]);
              *(u32x4*)(d.dst + (size_t)c * d.ld_dst + d.k0 + ks) = o; }
            d = dn; v0 = n0; v1 = n1;
        }
    }
    {
        bf16_t* XB = (bf16_t*)(p.ws + OFF_SA); float* part = (float*)(p.ws + OFF_PART);
        const int wid = tid >> 6, lane = tid & 63;
        for (int rl0 = bid * 8 + wid; rl0 < 8448; rl0 += 2 * G * 8) {
            const int rlb = rl0 + G * 8; const bool hasb = rlb < 8448; const int rl1 = hasb ? rlb : rl0;
            const int row0 = rl0 < 8192 ? 8192 * h + rl0 : TP + 256 * h + (rl0 - 8192), row1 = rl1 < 8192 ? 8192 * h + rl1 : TP + 256 * h + (rl1 - 8192);
            const float* s0 = row0 < TP ? p.x_prompt + (size_t)row0 * 1024 : p.x_sample + (size_t)(row0 - TP) * 1024;
            const float* s1 = row1 < TP ? p.x_prompt + (size_t)row1 * 1024 : p.x_sample + (size_t)(row1 - TP) * 1024;
            f32x4 a[4], b[4];
#pragma unroll
            for (int j = 0; j < 4; ++j) { a[j] = __builtin_nontemporal_load((const f32x4*)(s0 + j * 256 + lane * 4)); b[j] = __builtin_nontemporal_load((const f32x4*)(s1 + j * 256 + lane * 4)); }
            float sa = 0.f, sb = 0.f;
#pragma unroll
            for (int j = 0; j < 4; ++j) {
                sa += a[j][0] * a[j][0] + a[j][1] * a[j][1] + a[j][2] * a[j][2] + a[j][3] * a[j][3];
                sb += b[j][0] * b[j][0] + b[j][1] * b[j][1] + b[j][2] * b[j][2] + b[j][3] * b[j][3];
                *(u32x2*)(XB + (size_t)row0 * 1024 + j * 256 + lane * 4) = pk4(a[j]);
                if (hasb) *(u32x2*)(XB + (size_t)row1 * 1024 + j * 256 + lane * 4) = pk4(b[j]);
            }
#pragma unroll
            for (int o = 32; o >= 1; o >>= 1) { sa += __shfl_xor(sa, o); sb += __shfl_xor(sb, o); }
            if (lane < 32) { part[(size_t)row0 * 32 + lane] = lane == 0 ? sa : 0.f; if (hasb) part[(size_t)row1 * 32 + lane] = lane == 0 ? sb : 0.f; }
        }
    }
    {
        float* rope = (float*)(p.ws + OFF_ROPE);
        for (int idx = bid * 512 + tid; h == 0 && idx < 8196 * 8; idx += G * 512) {
            const int pi = idx >> 3, i = idx & 7;
            const int pos = pi < SEQ ? pi : 16384 + (pi - SEQ);
            const float angf = (float)pos * p.inv_freq[i];
            const double tt = (double)angf * 0.15915494309189533577;
            const float fr = (float)(tt - __builtin_floor(tt));
            rope[(size_t)pi * 16 + i] = __builtin_amdgcn_cosf(fr);
            rope[(size_t)pi * 16 + 8 + i] = __builtin_amdgcn_sinf(fr);
        }
    }
}

DI int crow(int reg, int h) { return (reg & 3) + 8 * (reg >> 2) + 4 * h; }
#define MFMA32(a, b, c) __builtin_amdgcn_mfma_f32_32x32x16_bf16((a), (b), (c), 0, 0, 0)

DI void attn_prompt_item(CParams& p, int l, int item, LAS unsigned char* lds) {
    const int tid = tidx(), wid = tid >> 6, lane = tid & 63;
    const int kh = item & 3, nb = (item >> 2) & 63, b = item >> 8;
    bf16_t* Q = (bf16_t*)(p.ws + OFF_SC);
    const bf16_t* KB = (const bf16_t*)(p.ws + OFF_SE + 2 * PANEL);
    const bf16_t* VB = (const bf16_t*)(p.ws + OFF_SE + 3 * PANEL);
    const bf16_t* SZA = (const bf16_t*)(p.ws + OFF_SD);
    LAS unsigned char* Ks = lds; LAS unsigned char* Vt = lds + 36864;
    __syncthreads();
    const long tk0 = (long)b * SEQ + 128 * (nb - 1);
#pragma unroll
    for (int e = 0; e < 4; ++e) {
        const int idx = tid + 512 * e, key = idx >> 3, seg = idx & 7;
        u32x4 v = {0u, 0u, 0u, 0u};
        if (nb > 0 || key >= 128) v = *(const u32x4*)(KB + (size_t)(tk0 + key) * 256 + kh * 64 + seg * 8);
        *(LAS u32x4*)(Ks + key * 144 + seg * 16) = v;
    }
    {
        const int key = tid & 255, half = tid >> 8; const bool ok = nb > 0 || key >= 128;
#pragma unroll
        for (int e = 0; e < 4; ++e) {
            u32x4 v = {0u, 0u, 0u, 0u};
            if (ok) v = *(const u32x4*)(VB + (size_t)(tk0 + key) * 256 + kh * 64 + half * 32 + e * 8);
#pragma unroll
            for (int jj = 0; jj < 4; ++jj) {
                const int d = half * 32 + e * 8 + 2 * jj;
                *(LAS unsigned short*)(Vt + d * 528 + key * 2) = (unsigned short)(v[jj] & 0xffffu);
                *(LAS unsigned short*)(Vt + (d + 1) * 528 + key * 2) = (unsigned short)(v[jj] >> 16);
            }
        }
    }
    __syncthreads();
    const int g = wid >> 1, rh = wid & 1, h = kh * 4 + g, r = lane & 31, hh = lane >> 5;
    const float sink = p.sinks[l * 16 + h];
    const float NEG = -__builtin_inff();
#pragma unroll 1
    for (int sbk = 0; sbk < 2; ++sbk) {
        const int wq = 2 * rh + sbk;
        const size_t tq = (size_t)b * SEQ + 128 * nb + 32 * wq + r;
        bf16x8 qf[4];
#pragma unroll
        for (int s = 0; s < 4; ++s) qf[s] = *(const bf16x8*)(Q + tq * 1024 + h * 64 + 16 * s + 8 * hh);
        f32x16 st[5];
#pragma unroll
        for (int kt = 0; kt < 5; ++kt) {
            const int jb = 32 * (wq + kt);
            f32x16 a;
#pragma unroll
            for (int i = 0; i < 16; ++i) a[i] = 0.f;
#pragma unroll
            for (int s = 0; s < 4; ++s) {
                const bf16x8 kf = *(const LAS bf16x8*)(Ks + (jb + r) * 144 + (16 * s + 8 * hh) * 2);
                a = MFMA32(kf, qf[s], a);
            }
            st[kt] = a;
        }
#pragma unroll
        for (int i = 0; i < 16; ++i) {
            const int kr = crow(i, hh);
            if (kr < r) st[0][i] = NEG;
            if (kr > r) st[4][i] = NEG;
        }
        if (nb == 0) {
#pragma unroll
            for (int kt = 0; kt < 4; ++kt)
                if (wq + kt < 4) {
#pragma unroll
                    for (int i = 0; i < 16; ++i) st[kt][i] = NEG;
                }
        }
        float mx = sink;
#pragma unroll
        for (int kt = 0; kt < 5; ++kt)
#pragma unroll
            for (int i = 0; i < 16; ++i) mx = fmaxf(mx, st[kt][i]);
        mx = fmaxf(mx, __shfl_xor(mx, 32));
        float sum = 0.f;
#pragma unroll
        for (int kt = 0; kt < 5; ++kt)
#pragma unroll
            for (int i = 0; i < 16; ++i) { const float e = __expf(st[kt][i] - mx); st[kt][i] = e; sum += e; }
        sum += __shfl_xor(sum, 32);
        sum += __expf(sink - mx);
        const float inv = 1.f / sum;
        f32x16 o0, o1;
#pragma unroll
        for (int i = 0; i < 16; ++i) { o0[i] = 0.f; o1[i] = 0.f; }
#pragma unroll
        for (int kt = 0; kt < 5; ++kt) {
            const int jb = 32 * (wq + kt);
#pragma unroll
            for (int s2 = 0; s2 < 2; ++s2) {
                u32x4 pw;
                pw[0] = pk2(st[kt][8 * s2 + 0], st[kt][8 * s2 + 1]); pw[1] = pk2(st[kt][8 * s2 + 2], st[kt][8 * s2 + 3]);
                pw[2] = pk2(st[kt][8 * s2 + 4], st[kt][8 * s2 + 5]); pw[3] = pk2(st[kt][8 * s2 + 6], st[kt][8 * s2 + 7]);
                const bf16x8 xs = __builtin_bit_cast(bf16x8, pw);
                const int ko = (jb + 16 * s2 + 4 * hh) * 2;
                const s16x4 v0a = *(const LAS s16x4*)(Vt + r * 528 + ko), v0b = *(const LAS s16x4*)(Vt + r * 528 + ko + 16);
                const s16x4 v1a = *(const LAS s16x4*)(Vt + (r + 32) * 528 + ko), v1b = *(const LAS s16x4*)(Vt + (r + 32) * 528 + ko + 16);
                const bf16x8 vf0 = __builtin_shufflevector(v0a, v0b, 0, 1, 2, 3, 4, 5, 6, 7), vf1 = __builtin_shufflevector(v1a, v1b, 0, 1, 2, 3, 4, 5, 6, 7);
                o0 = MFMA32(vf0, xs, o0); o1 = MFMA32(vf1, xs, o1);
            }
        }
#pragma unroll
        for (int g4 = 0; g4 < 4; ++g4) {
            const int d0 = 8 * g4 + 4 * hh;
            {
                const size_t off = tq * 1024 + h * 64 + d0;
                const f32x4 z = unpk4(*(const u32x2*)(SZA + off));
                f32x4 v; v[0] = o0[4 * g4] * inv * z[0]; v[1] = o0[4 * g4 + 1] * inv * z[1]; v[2] = o0[4 * g4 + 2] * inv * z[2]; v[3] = o0[4 * g4 + 3] * inv * z[3];
                *(u32x2*)(Q + off) = pk4(v);
            }
            {
                const size_t off = tq * 1024 + h * 64 + 32 + d0;
                const f32x4 z = unpk4(*(const u32x2*)(SZA + off));
                f32x4 v; v[0] = o1[4 * g4] * inv * z[0]; v[1] = o1[4 * g4 + 1] * inv * z[1]; v[2] = o1[4 * g4 + 2] * inv * z[2]; v[3] = o1[4 * g4 + 3] * inv * z[3];
                *(u32x2*)(Q + off) = pk4(v);
            }
        }
    }
}

DI void attn_sample_item(CParams& p, int l, int item, LAS unsigned char* lds) {
    const int tid = tidx(), wid = tid >> 6, lane = tid & 63;
    const int sb = item >> 1, h = (item & 1) * 8 + wid, kh = h >> 2;
    bf16_t* Q = (bf16_t*)(p.ws + OFF_SC);
    const bf16_t* KB = (const bf16_t*)(p.ws + OFF_SE + 2 * PANEL);
    const bf16_t* VB = (const bf16_t*)(p.ws + OFF_SE + 3 * PANEL);
    const bf16_t* SZA = (const bf16_t*)(p.ws + OFF_SD);
    LAS float* wq_ = (LAS float*)(lds + wid * 4096);
    LAS float* sc = wq_ + 256;
    const size_t tq0 = (size_t)TP + 4 * sb;
    const float sink = p.sinks[l * 16 + h];
    __syncthreads();
#pragma unroll
    for (int i = 0; i < 4; ++i) wq_[i * 64 + lane] = bf1(Q[(tq0 + i) * 1024 + h * 64 + lane]);
    __syncthreads();
    const int kq = lane >> 4, ds = lane & 15;
    f32x4 qv[4];
#pragma unroll
    for (int i = 0; i < 4; ++i) qv[i] = *(const LAS f32x4*)(wq_ + i * 64 + ds * 4);
    const size_t cbase = ((size_t)(l * 128 + sb) * 128 * 4 + kh) * 64;
    const float* ck = p.cache_k + cbase + ds * 4; const float* cv = p.cache_v + cbase + ds * 4;
#pragma unroll 1
    for (int it0 = 0; it0 < 32; it0 += 8) {
        f32x4 kv[8];
#pragma unroll
        for (int u = 0; u < 8; ++u) kv[u] = *(const f32x4*)(ck + (size_t)(4 * (it0 + u) + kq) * 256);
#pragma unroll
        for (int u = 0; u < 8; ++u) {
            const int c = 4 * (it0 + u) + kq;
            float d[4];
#pragma unroll
            for (int i = 0; i < 4; ++i) {
                float x = kv[u][0] * qv[i][0] + kv[u][1] * qv[i][1] + kv[u][2] * qv[i][2] + kv[u][3] * qv[i][3];
                x += __shfl_xor(x, 1); x += __shfl_xor(x, 2); x += __shfl_xor(x, 4); x += __shfl_xor(x, 8);
                d[i] = x;
            }
            const float my = ds == 0 ? d[0] : ds == 1 ? d[1] : ds == 2 ? d[2] : d[3];
            if (ds < 4) sc[c * 4 + ds] = my;
        }
    }
    {
        const f32x4 kv = unpk4(*(const u32x2*)(KB + (tq0 + kq) * 256 + kh * 64 + ds * 4));
        float d[4];
#pragma unroll
        for (int i = 0; i < 4; ++i) {
            float x = kv[0] * qv[i][0] + kv[1] * qv[i][1] + kv[2] * qv[i][2] + kv[3] * qv[i][3];
            x += __shfl_xor(x, 1); x += __shfl_xor(x, 2); x += __shfl_xor(x, 4); x += __shfl_xor(x, 8);
            d[i] = x;
        }
        const float my = ds == 0 ? d[0] : ds == 1 ? d[1] : ds == 2 ? d[2] : d[3];
        if (ds < 4) sc[(128 + kq) * 4 + ds] = my;
    }
    __syncthreads();
#pragma unroll
    for (int i = 0; i < 4; ++i) {
        const float NEG = -__builtin_inff();
        float s0 = sc[lane * 4 + i], s1 = sc[(lane + 64) * 4 + i], s2 = lane < 4 ? sc[(128 + lane) * 4 + i] : NEG;
        if (lane < i) s0 = NEG;
        if (lane > i) s2 = NEG;
        float mx = fmaxf(fmaxf(s0, s1), fmaxf(s2, sink));
#pragma unroll
        for (int o = 32; o >= 1; o >>= 1) mx = fmaxf(mx, __shfl_xor(mx, o));
        const float e0 = __expf(s0 - mx), e1 = __expf(s1 - mx), e2 = __expf(s2 - mx);
        float sum = e0 + e1 + e2;
#pragma unroll
        for (int o = 32; o >= 1; o >>= 1) sum += __shfl_xor(sum, o);
        sum += __expf(sink - mx);
        const float inv = 1.f / sum;
        sc[lane * 4 + i] = e0 * inv; sc[(lane + 64) * 4 + i] = e1 * inv; if (lane < 4) sc[(128 + lane) * 4 + i] = e2 * inv;
    }
    __syncthreads();
    f32x4 o[4];
#pragma unroll
    for (int i = 0; i < 4; ++i) o[i] = (f32x4){0.f, 0.f, 0.f, 0.f};
#pragma unroll 1
    for (int it0 = 0; it0 < 32; it0 += 8) {
        f32x4 vv[8];
#pragma unroll
        for (int u = 0; u < 8; ++u) vv[u] = *(const f32x4*)(cv + (size_t)(4 * (it0 + u) + kq) * 256);
#pragma unroll
        for (int u = 0; u < 8; ++u) {
            const f32x4 pr = *(const LAS f32x4*)(sc + (4 * (it0 + u) + kq) * 4);
#pragma unroll
            for (int i = 0; i < 4; ++i) o[i] += vv[u] * pr[i];
        }
    }
    {
        const f32x4 vv = unpk4(*(const u32x2*)(VB + (tq0 + kq) * 256 + kh * 64 + ds * 4));
        const f32x4 pr = *(const LAS f32x4*)(sc + (128 + kq) * 4);
#pragma unroll
        for (int i = 0; i < 4; ++i) o[i] += vv * pr[i];
    }
#pragma unroll
    for (int i = 0; i < 4; ++i)
#pragma unroll
        for (int j = 0; j < 4; ++j) { float x = o[i][j]; x += __shfl_xor(x, 16); x += __shfl_xor(x, 32); o[i][j] = x; }
    {
        const f32x4 mine = kq == 0 ? o[0] : kq == 1 ? o[1] : kq == 2 ? o[2] : o[3];
        const size_t off = (tq0 + kq) * 1024 + h * 64 + ds * 4;
        const f32x4 z = unpk4(*(const u32x2*)(SZA + off));
        *(u32x2*)(Q + off) = pk4(mine * z);
    }
}

template <int W>
DI void pool_prompt_body(const bf16_t* U, bf16_t* R, int t0) {
    f32x2 prev[16], cur[16];
#pragma unroll
    for (int j = 0; j < 16; ++j) {
        prev[j] = (f32x2){0.f, 0.f};
        if (j >= 17 - W) { const int t = t0 - 16 + j; if (t >= 0) { const unsigned u = *(const unsigned*)(U + (size_t)t * 1024); prev[j] = (f32x2){bflo(u), bfhi(u)}; } }
    }
#pragma unroll 1
    for (int ch = 0; ch < 4; ++ch) {
        const int tb = t0 + ch * 16;
#pragma unroll
        for (int j = 0; j < 16; ++j) { const unsigned u = *(const unsigned*)(U + (size_t)(tb + j) * 1024); cur[j] = (f32x2){bflo(u), bfhi(u)}; }
#pragma unroll
        for (int i = 0; i < 16; ++i) {
            f32x2 sum = cur[i];
#pragma unroll
            for (int j = 1; j < W; ++j) sum += (i - j >= 0) ? cur[i - j >= 0 ? i - j : 0] : prev[i - j >= 0 ? 0 : 16 + i - j];
            const int t = tb + i;
            const float ic = 1.f / (float)(t + 1 < W ? t + 1 : W);
            const f32x2 r = sum * ic - cur[i];
            *(unsigned*)(R + (size_t)t * 1024) = pk2(r[0], r[1]);
        }
#pragma unroll
        for (int j = 0; j < 16; ++j) prev[j] = cur[j];
    }
}

DI void pool_prompt_item(CParams& p, int item) {
    const int tid = tidx(), g = __builtin_amdgcn_readfirstlane(tid >> 7);
    const int b = item >> 7, t0 = (item & 127) * 64;
    const bf16_t* U = (const bf16_t*)(p.ws + OFF_SB) + (size_t)b * SEQ * 1024 + 2 * tid;
    bf16_t* R = (bf16_t*)(p.ws + OFF_SF) + (size_t)b * SEQ * 1024 + 2 * tid;
    if (g == 0) pool_prompt_body<2>(U, R, t0);
    else if (g == 1) pool_prompt_body<4>(U, R, t0);
    else if (g == 2) pool_prompt_body<8>(U, R, t0);
    else pool_prompt_body<16>(U, R, t0);
}

DI void pool_sample_item(CParams& p, int l, int item) {
    const int tid = tidx(), g = tid >> 7;
    const float iw = g == 0 ? 0.5f : g == 1 ? 0.25f : g == 2 ? 0.125f : 0.0625f;
    {
        const int sb = item;
        const float* st = p.state_pool + (size_t)(l * 128 + sb) * 15 * 1024 + 2 * tid;
        float* np = p.out + O_PS + (size_t)(l * 128 + sb) * 15 * 1024 + 2 * tid;
        const bf16_t* U = (const bf16_t*)(p.ws + OFF_SB) + ((size_t)TP + 4 * sb) * 1024 + 2 * tid;
        bf16_t* R = (bf16_t*)(p.ws + OFF_SF) + ((size_t)TP + 4 * sb) * 1024 + 2 * tid;
        f32x2 pv[19], cs[20];
#pragma unroll
        for (int j = 0; j < 15; ++j) pv[j] = *(const f32x2*)(st + (size_t)j * 1024);
#pragma unroll
        for (int j = 0; j < 4; ++j) { const unsigned u = *(const unsigned*)(U + (size_t)j * 1024); pv[15 + j] = (f32x2){bflo(u), bfhi(u)}; }
#pragma unroll
        for (int j = 4; j < 15; ++j) *(f32x2*)(np + (size_t)(j - 4) * 1024) = pv[j];
        cs[0] = (f32x2){0.f, 0.f};
#pragma unroll
        for (int j = 0; j < 19; ++j) cs[j + 1] = cs[j] + pv[j];
#pragma unroll
        for (int i = 0; i < 4; ++i) {
            const f32x2 start = g == 0 ? cs[14 + i] : g == 1 ? cs[12 + i] : g == 2 ? cs[8 + i] : cs[i];
            const f32x2 r = (cs[16 + i] - start) * iw - pv[15 + i];
            *(unsigned*)(R + (size_t)i * 1024) = pk2(r[0], r[1]);
        }
    }
}

DI void cache_copy_item(CParams& p, int l, int item) {
    const int tid = tidx(), sb = item >> 1;
    const size_t base = (size_t)(l * 128 + sb) * 128 * 256;
    const f32x4* src = (const f32x4*)(((item & 1) ? p.cache_v : p.cache_k) + base + 4 * 256) + tid;
    f32x4* dst = (f32x4*)(p.out + ((item & 1) ? O_VS : O_KS) + base) + tid;
#pragma unroll 1
    for (int i0 = 0; i0 < 15; i0 += 5) {
        f32x4 v[5];
#pragma unroll
        for (int u = 0; u < 5; ++u) v[u] = __builtin_nontemporal_load(src + (size_t)(i0 + u) * 512);
#pragma unroll
        for (int u = 0; u < 5; ++u) __builtin_nontemporal_store(v[u], dst + (size_t)(i0 + u) * 512);
    }
    if (tid < 256) { const f32x4 v = __builtin_nontemporal_load(src + (size_t)15 * 512); __builtin_nontemporal_store(v, dst + (size_t)15 * 512); }
}

DI void phase2(CParams& p, int l, LAS unsigned char* lds, int h, int c, int G) {
    for (int it = c; it < 704; it += G) {
        if (it < 128) attn_sample_item(p, l, 128 * h + it, lds);
        else if (it < 384) attn_prompt_item(p, l, (h << 8) | (it - 128), lds);
        else if (it < 512) cache_copy_item(p, l, 128 * h + (it - 384));
        else if (it < 640) pool_prompt_item(p, 128 * h + (it - 512));
        else pool_sample_item(p, l, 64 * h + (it - 640));
    }
}

DI void convert_p(CParams& p, int l, int h, int c, int G) {
    bf16_t* PB = (bf16_t*)(p.ws + OFF_SE);
    const size_t n8 = (size_t)(8192 + 256) * 256 / 8;
    for (size_t i = (size_t)c * 512 + tidx(); i < n8; i += (size_t)G * 512) {
        const size_t el = i * 8, e = el < (size_t)8192 * 256 ? (size_t)h * 8192 * 256 + el : (size_t)TP * 256 + (size_t)h * 256 * 256 + (el - (size_t)8192 * 256);
        const float* src = e < (size_t)TP * 256 ? p.p_prompt + (size_t)l * TP * 256 + e : p.p_sample + (size_t)l * TS * 256 + (e - (size_t)TP * 256);
        const f32x4 a = __builtin_nontemporal_load((const f32x4*)src), b = __builtin_nontemporal_load((const f32x4*)(src + 4));
        u32x4 o; o[0] = pk2(a[0], a[1]); o[1] = pk2(a[2], a[3]); o[2] = pk2(b[0], b[1]); o[3] = pk2(b[2], b[3]);
        *(u32x4*)(PB + e) = o;
    }
}

#define XB_TMO      128
#define XB_XCNT(j)  (256  + 64 * (j))
#define XB_XSUB(j)  (1280 + 64 * (j))
#define XB_XGEN(j)  (2304 + 64 * (j))
#define XB_TOP      3328
#define XB_TOPGEN   3392
#define XCD_BAR_WORDS 3456
#define XB_SPIN_CAP (1u << 20)
DI unsigned xb_ld(unsigned* p) { return __hip_atomic_load(p, __ATOMIC_RELAXED, __HIP_MEMORY_SCOPE_AGENT); }
DI unsigned xb_add(unsigned* p, unsigned v) { return __hip_atomic_fetch_add(p, v, __ATOMIC_RELAXED, __HIP_MEMORY_SCOPE_AGENT); }
DI unsigned xb_xcc_id() { return (unsigned)__builtin_amdgcn_s_getreg((3 << 11) | 20) & 0xFu; }
#define XB_SPIN(cond, bar) do { unsigned _sp = 0; while (cond) { __builtin_amdgcn_s_sleep(1); \
    if ((++_sp & 255u) == 0u) { if (xb_ld(&(bar)[XB_TMO])) break; if (_sp > XB_SPIN_CAP) { atomicAdd(&(bar)[XB_TMO], 1u); break; } } } } while (0)
struct XcdBarrier { unsigned* bar; unsigned x; volatile LAS unsigned* st; unsigned total; };
DI XcdBarrier xcd_barrier_post(unsigned* bar, volatile LAS unsigned* st, unsigned total) {
    XcdBarrier b; b.bar = bar; b.x = xb_xcc_id(); b.st = st; b.total = total;
    if (threadIdx.x == 0) (void)xb_add(&bar[XB_XCNT(b.x)], 1u);
    return b;
}
DI void xcd_barrier_complete(unsigned* bar, unsigned x, unsigned G, unsigned& nloc, unsigned& nx) {
    unsigned sum, cnt, mine, sp = 0u;
    for (;;) {
        sum = 0u; cnt = 0u; mine = 0u;
#pragma unroll
        for (unsigned j = 0; j < 16; ++j) { const unsigned c = xb_ld(&bar[XB_XCNT(j)]); sum += c; cnt += (c > 0u) ? 1u : 0u; mine = (j == x) ? c : mine; }
        if (sum == G) break;
        __builtin_amdgcn_s_sleep(1);
        if ((++sp & 255u) == 0u) { if (xb_ld(&bar[XB_TMO])) break; if (sp > XB_SPIN_CAP) { atomicAdd(&bar[XB_TMO], 1u); break; } }
    }
    nloc = mine > 0u ? mine : 1u; nx = cnt > 0u ? cnt : 1u;
}
DI void xcd_barrier(const XcdBarrier& b) {
    asm volatile("s_waitcnt vmcnt(0)" ::: "memory");
    __syncthreads();
    if (threadIdx.x == 0) {
        unsigned* bar = b.bar;
        __builtin_amdgcn_s_waitcnt(0);
        unsigned nloc = b.st[0], nx = b.st[1];
        if (nloc == 0u) { xcd_barrier_complete(bar, b.x, b.total, nloc, nx); b.st[0] = nloc; b.st[1] = nx; }
        const unsigned old = xb_add(&bar[XB_XSUB(b.x)], 1u);
        const unsigned gen = old / nloc;
        if (old + 1u == (gen + 1u) * nloc) {
            __builtin_amdgcn_fence(__ATOMIC_RELEASE, "agent");
            asm volatile("s_waitcnt vmcnt(0)" ::: "memory");
            const unsigned og = xb_add(&bar[XB_TOP], 1u);
            const unsigned tg = og / nx;
            if (og + 1u == (tg + 1u) * nx) xb_add(&bar[XB_TOPGEN], 1u);
            else XB_SPIN(xb_ld(&bar[XB_TOPGEN]) == tg, bar);
            __builtin_amdgcn_fence(__ATOMIC_ACQUIRE, "agent");
            xb_add(&bar[XB_XGEN(b.x)], 1u);
            asm volatile("s_waitcnt vmcnt(0)" ::: "memory");
        } else {
            XB_SPIN(xb_ld(&bar[XB_XGEN(b.x)]) == gen, bar);
            __builtin_amdgcn_fence(__ATOMIC_ACQUIRE, "agent");
            asm volatile("s_waitcnt vmcnt(0)" ::: "memory");
        }
    }
    __syncthreads();
}

DI void flag_wait(unsigned* flag) {
    if (threadIdx.x == 0) {
        unsigned sp = 0;
        while (xb_ld(flag) == 0u) { __builtin_amdgcn_s_sleep(2); if (++sp > (1u << 22)) break; }
        __builtin_amdgcn_fence(__ATOMIC_ACQUIRE, "agent");
        asm volatile("s_waitcnt vmcnt(0)" ::: "memory");
    }
    __syncthreads();
}
__global__ void __launch_bounds__(512, 2) mega(Params p_, int ph_lo, int ph_hi) {
    extern __shared__ __attribute__((aligned(16))) unsigned char shm[];
    LAS unsigned char* lds = (LAS unsigned char*)shm;
    const int G = gridDim.x, GH = G >> 1;
    volatile LAS unsigned* bst = (volatile LAS unsigned*)(lds + STAGE_BYTES);
    unsigned* barw = (unsigned*)(p_.ws + OFF_BAR);
    constexpr int BSTRIDE = XCD_BAR_WORDS + 64;
    const bool single = ph_hi - ph_lo > 1;
    const int c = blockIdx.x;
    if (single) {
        if (threadIdx.x < 8) bst[threadIdx.x] = 0u;
        __syncthreads();
    }
    const int h = c & 1, ch = c >> 1;
    unsigned* flags = barw + 3 * BSTRIDE - 32;
    XcdBarrier xbar;
    if (single) xbar = xcd_barrier_post(barw + (1 + h) * BSTRIDE, bst + 4, (unsigned)GH);
    if (ph_hi < 0) cg::this_grid().sync();
    for (int ph = ph_lo; ph < ph_hi; ++ph) {
        CParams* pq = (CParams*)__builtin_amdgcn_kernarg_segment_ptr(); asm volatile("" : "+s"(pq)); CParams& p = *pq;
        if (ph == 0) { if (ONLY < 0 || ONLY == 0) phase0(p, lds, h, ch, GH); }
        else {
            const int l = (ph - 1) / 7, s = (ph - 1) % 7;
            if (single && l == 0 && ((s == 0 && h == 1) || (s == 3 && h == 0))) flag_wait(flags + (1 - h));
            if ((s == 0 || s == 2) && (ONLY < 0 || ONLY == 1)) {
                SchedZ S; S.o.init(33, s == 0 ? 15 : 11); S.G = GH; S.c = ch; S.mode = s == 0 ? 0 : 1; S.l = l; S.h = h; S.p = pq;
                EpiZ E; E.l = l; E.p = pq; E.rs = (const LAS float*)(lds + STAGE_BYTES + 32);
                rstd_table(S, (const float*)(p.ws + OFF_PART), (LAS float*)(lds + STAGE_BYTES + 32));
                gemm_phase(lds, S, E);
            } else if (s == 1 && (ONLY < 0 || ONLY == 2)) {
                phase2(p, l, lds, h, ch, GH);
            } else if (s == 3 && (ONLY < 0 || ONLY == 3)) {
                SchedPool S; S.o.init(32, 4); S.G = GH; S.c = ch; S.l = l; S.h = h; S.p = pq;
                EpiPool E; E.l = l; E.p = pq;
                gemm_phase(lds, S, E);
                mini_phase(p, l, 3, ch, GH, h, lds);
            } else if (s == 4 && (ONLY < 0 || ONLY == 4)) {
                SchedMerge S; S.o.init(32, 4); S.G = GH; S.c = ch; S.l = l; S.h = h; S.p = pq;
                EpiMerge E; E.p = pq;
                convert_p(p, l, h, ch, GH);
                gemm_phase(lds, S, E);
                mini_phase(p, l, 4, ch, GH, h, lds);
            } else if (s == 5 && (ONLY < 0 || ONLY == 5)) {
                SchedRes1 S; S.o.init(32, 4); S.G = GH; S.c = ch; S.l = l; S.h = h; S.p = pq;
                EpiRes1 E; E.l = l; E.p = pq;
                gemm_phase(lds, S, E);
                mini_phase(p, l, 5, ch, GH, h, lds);
            } else if (s == 6 && (ONLY < 0 || ONLY == 6)) {
                SchedPlain S; S.o.init(32, 4); S.G = GH; S.c = ch; S.l = l; S.h = h; S.p = pq;
                EpiRes2 E; E.l = l; E.p = pq;
                gemm_phase(lds, S, E);
                mini_phase(p, l, 6, ch, GH, h, lds);
            }
        }
        if (ph + 1 < ph_hi) {
            xcd_barrier(xbar);
            if (ph == 0 && ch == 0 && threadIdx.x == 0) {
                __builtin_amdgcn_fence(__ATOMIC_RELEASE, "agent");
                asm volatile("s_waitcnt vmcnt(0)" ::: "memory");
                __hip_atomic_store(flags + h, 1u, __ATOMIC_RELAXED, __HIP_MEMORY_SCOPE_AGENT);
            }
        }
    }
}

extern "C" void kernel_launch(void* const* d_in, const int* in_sizes, int n_in, void* d_out, int out_size, void* d_ws, size_t ws_size, hipStream_t stream) {
    (void)in_sizes; (void)n_in; (void)out_size;
    if (ws_size < WS_NEED) { fprintf(stderr, "workspace too small: %zu < %zu\n", ws_size, (size_t)WS_NEED); return; }
    Params p{};
    p.x_prompt = (const float*)d_in[0]; p.x_sample = (const float*)d_in[1]; p.cache_k = (const float*)d_in[2]; p.cache_v = (const float*)d_in[3];
    p.state_pool = (const float*)d_in[4]; p.p_prompt = (const float*)d_in[5]; p.p_sample = (const float*)d_in[6]; p.norm_g = (const float*)d_in[7];
    p.w_in = (const float*)d_in[8]; p.q_norm_g = (const float*)d_in[9]; p.k_norm_g = (const float*)d_in[10]; p.sinks = (const float*)d_in[11];
    p.pool_map = (const float*)d_in[12]; p.pool_scale = (const float*)d_in[13]; p.w_proj_pool = (const float*)d_in[14]; p.w_proj_attn = (const float*)d_in[15];
    p.w_out = (const float*)d_in[16]; p.w_ple = (const float*)d_in[17]; p.w_ple_gate = (const float*)d_in[18];
    p.out = (float*)d_out; p.ws = (unsigned char*)d_ws;
    for (int i = 0; i < 8; ++i) p.inv_freq[i] = (float)pow(500000.0, -(double)i / 8.0);
    constexpr int LDS_BYTES = STAGE_BYTES + 32 + 8192;
    static bool attr_set = false;
    if (!attr_set) { hipFuncSetAttribute((const void*)mega, hipFuncAttributeMaxDynamicSharedMemorySize, LDS_BYTES); attr_set = true; }
    constexpr int NPH = 15;
#if COOP
    static int grid_blocks = 0;
    if (!grid_blocks) {
        int dev = 0, cus = 0, per_cu = 0;
        hipGetDevice(&dev);
        hipDeviceGetAttribute(&cus, hipDeviceAttributeMultiprocessorCount, dev);
        hipOccupancyMaxActiveBlocksPerMultiprocessor(&per_cu, mega, 512, LDS_BYTES);
        if (per_cu > 1) per_cu = 1;
        grid_blocks = cus * per_cu;
    }
    int lo = 0, hi = NPH;
    (void)hipMemsetAsync((unsigned char*)d_ws + OFF_BAR, 0, 3 * (XCD_BAR_WORDS + 64) * 4, stream);
    void* args[] = {&p, &lo, &hi};
    hipError_t e = hipLaunchCooperativeKernel((const void*)mega, dim3(grid_blocks), dim3(512), args, LDS_BYTES, stream);
    if (e != hipSuccess) fprintf(stderr, "cooperative launch failed: %s (grid %d)\n", hipGetErrorString(e), grid_blocks);
#else
    for (int ph = 0; ph < NPH; ++ph) hipLaunchKernelGGL(mega, dim3(256), dim3(512), LDS_BYTES, stream, p, ph, ph + 1);
#endif
}
```
